# Optimizing an MI355X kernel written in HIP

```python
import jax, jax.numpy as jnp
from jax import lax
import numpy as np

D_MODEL = 1024
BATCH = 8
SEQ = 2048
DEPTH = 4

N_MIXERS = 2
EXPAND = 2
D_INNER = EXPAND * D_MODEL
EPS = 1e-6

SGU_CHUNK = 128
SGU_GROUPS = 8
SGU_GROUP_DIM = D_INNER // SGU_GROUPS
A_IN = 3 * D_INNER

GLA_HEADS = 4
GLA_DK_TOTAL = D_MODEL // 2
GLA_DK = GLA_DK_TOTAL // GLA_HEADS
GLA_DV = D_INNER // GLA_HEADS
GLA_GATE_RANK = 16
GLA_GATE_TAU = 16.0
GLA_CHUNK = 64
B_SPLITS = [GLA_DK_TOTAL, 2 * GLA_DK_TOTAL, 2 * GLA_DK_TOTAL + D_INNER, 2 * GLA_DK_TOTAL + 2 * D_INNER]
B_IN = 2 * GLA_DK_TOTAL + 2 * D_INNER + GLA_GATE_RANK

N_A = (DEPTH + 1) // 2
N_B = DEPTH // 2

kernel_name = "hybrid_sgu_gla_adaln_trunk"


def rmsnorm(x, g):
    xf = x.astype(jnp.float32)
    y = xf * lax.rsqrt(jnp.mean(xf * xf, axis=-1, keepdims=True) + EPS)
    return (y * g.astype(jnp.float32)).astype(x.dtype)


def sgu_branch(h, w_in, w_s, b_s, g_v, w_out):
    bsz, seq, _ = h.shape
    u, v, z = jnp.split(h @ w_in, 3, axis=-1)
    u = jax.nn.gelu(u)
    v = rmsnorm(jax.nn.gelu(v), g_v)
    n_c = seq // SGU_CHUNK
    v = v.reshape(bsz, n_c, SGU_CHUNK, SGU_GROUPS, SGU_GROUP_DIM)
    causal = jnp.tril(jnp.ones((SGU_CHUNK, SGU_CHUNK), dtype=bool))
    w = jnp.where(causal[None], w_s, 0)
    mixed = jnp.einsum('gts,bcsgd->bctgd', w, v) + b_s.T[None, None, :, :, None]
    y = u * mixed.reshape(bsz, seq, D_INNER) * jax.nn.silu(z)
    return y @ w_out


def gla_branch(h, w_in, w_gate_up, b_gate, g_o, w_out):
    f32 = jnp.float32
    bsz, seq, _ = h.shape
    q, k, v, z, a_lr = jnp.split(h @ w_in, B_SPLITS, axis=-1)
    log_a = jax.nn.log_sigmoid((a_lr @ w_gate_up + b_gate).astype(f32)) / GLA_GATE_TAU
    L = GLA_CHUNK
    n_c = seq // L

    def heads(t, d):
        return t.astype(f32).reshape(bsz, n_c, L, GLA_HEADS, d).transpose(0, 1, 3, 2, 4)

    q = heads(q, GLA_DK) * (GLA_DK ** -0.5)
    k = heads(k, GLA_DK)
    v = heads(v, GLA_DV)
    b = jnp.cumsum(heads(log_a, GLA_DK), axis=3)
    b_last = b[:, :, :, -1:, :]
    q_dec = q * jnp.exp(b)
    k_inv = k * jnp.exp(-b)
    k_state = k * jnp.exp(b_last - b)
    causal = jnp.tril(jnp.ones((L, L), dtype=bool))
    attn = jnp.where(causal, jnp.einsum('bchtk,bchsk->bchts', q_dec, k_inv), 0.0)
    o_intra = jnp.einsum('bchts,bchsv->bchtv', attn, v)
    decay = jnp.exp(b_last[:, :, :, 0, :])

    def step(state, inp):
        q_c, ks_c, v_c, d_c = inp
        o = jnp.einsum('bhtk,bhkv->bhtv', q_c, state)
        state = d_c[..., None] * state + jnp.einsum('bhsk,bhsv->bhkv', ks_c, v_c)
        return state, o

    s0 = jnp.zeros((bsz, GLA_HEADS, GLA_DK, GLA_DV), f32)
    _, o_inter = lax.scan(step, s0, (q_dec.swapaxes(0, 1), k_state.swapaxes(0, 1),
                                     v.swapaxes(0, 1), decay.swapaxes(0, 1)))
    o = o_intra + o_inter.swapaxes(0, 1)
    o = rmsnorm(o, g_o)
    o = o.transpose(0, 1, 3, 2, 4).reshape(bsz, seq, D_INNER).astype(h.dtype)
    return (o * jax.nn.silu(z)) @ w_out


def setup_inputs(seed: int = 0) -> dict:
    key = jax.random.key(seed)
    ks = jax.random.split(key, 20)
    nrm = lambda k, shape, s: jax.random.normal(k, shape, jnp.float32) * s
    return {
        "x": nrm(ks[0], (BATCH, SEQ, D_MODEL), 1.0),
        "c": nrm(ks[1], (BATCH, D_MODEL), 1.0),
        "w_ada": nrm(ks[2], (DEPTH, D_MODEL, 3 * D_MODEL), D_MODEL ** -0.5),
        "b_ada": nrm(ks[3], (DEPTH, 3 * D_MODEL), 0.02),
        "g_norm": 1.0 + nrm(ks[4], (DEPTH, D_MODEL), 0.02),
        "a_w_in": nrm(ks[5], (N_A, D_MODEL, A_IN), D_MODEL ** -0.5),
        "a_w_s": nrm(ks[6], (N_A, SGU_GROUPS, SGU_CHUNK, SGU_CHUNK), SGU_CHUNK ** -0.5),
        "a_b_s": 1.0 + nrm(ks[7], (N_A, SGU_GROUPS, SGU_CHUNK), 0.02),
        "a_g_v": 1.0 + nrm(ks[8], (N_A, D_INNER), 0.02),
        "a_w_out": nrm(ks[9], (N_A, D_INNER, D_MODEL), D_INNER ** -0.5),
        "b_w_in": nrm(ks[10], (N_B, D_MODEL, B_IN), D_MODEL ** -0.5),
        "b_w_gate_up": nrm(ks[11], (N_B, GLA_GATE_RANK, GLA_DK_TOTAL), GLA_GATE_RANK ** -0.5),
        "b_b_gate": nrm(ks[12], (N_B, GLA_DK_TOTAL), 0.1),
        "b_g_o": 1.0 + nrm(ks[13], (N_B, GLA_DV), 0.02),
        "b_w_out": nrm(ks[14], (N_B, D_INNER, D_MODEL), D_INNER ** -0.5),
        "g_final": 1.0 + nrm(ks[15], (D_MODEL,), 0.02),
    }


def reference(x, c, w_ada, b_ada, g_norm, a_w_in, a_w_s, a_b_s, a_g_v, a_w_out,
              b_w_in, b_w_gate_up, b_b_gate, b_g_o, b_w_out, g_final):
    cond = jax.nn.silu(c)
    for layer in range(DEPTH):
        mod = (cond @ w_ada[layer] + b_ada[layer])[:, None, :]
        shift, scale, gate = jnp.split(mod, 3, axis=-1)
        h = rmsnorm(x, g_norm[layer]) * (1 + scale) + shift
        j = layer // N_MIXERS
        if layer % N_MIXERS == 0:
            y = sgu_branch(h, a_w_in[j], a_w_s[j], a_b_s[j], a_g_v[j], a_w_out[j])
        else:
            y = gla_branch(h, b_w_in[j], b_w_gate_up[j], b_b_gate[j], b_g_o[j], b_w_out[j])
        x = x + gate * y
    return rmsnorm(x, g_final)
```

```cpp
#define MK_PER_PHASE 1
#define NAIVE_MIX 1
#define NAIVE_GLA 1
#include <hip/hip_runtime.h>
#include <cstdio>
#include <cstdint>

#ifndef MK_PER_PHASE
#define MK_PER_PHASE 0
#endif
#ifndef NAIVE_MIX
#define NAIVE_MIX 0
#endif
#ifndef NAIVE_GLA
#define NAIVE_GLA 0
#endif

constexpr int D = 1024, BATCH = 8, SEQ = 2048, M = BATCH * SEQ, DI = 2048, DEPTH = 4;
constexpr int A_IN = 3 * DI;
constexpr int B_N = 5120, B_INW = 5136;
constexpr int SGU_T = 128, SGU_G = 8, SGU_GD = 256;
constexpr int GH = 4, GDK = 128, GDV = 512, GL = 64, GNC = SEQ / GL, GRANK = 16;
constexpr float EPS = 1e-6f;

#define GAS __attribute__((address_space(1)))
#define LAS __attribute__((address_space(3)))
typedef unsigned short bf16;
typedef unsigned v4u __attribute__((ext_vector_type(4)));
typedef unsigned v2u __attribute__((ext_vector_type(2)));
typedef float f32x4 __attribute__((ext_vector_type(4)));
typedef float f32x2 __attribute__((ext_vector_type(2)));
typedef short bf16x8 __attribute__((ext_vector_type(8)));
typedef short bf16x4 __attribute__((ext_vector_type(4)));

__device__ __forceinline__ unsigned f2bf(float f) { unsigned u = __builtin_bit_cast(unsigned, f); return (u + 0x7fffu + ((u >> 16) & 1u)) >> 16; }
__device__ __forceinline__ unsigned pk2(float lo, float hi) { return f2bf(lo) | (f2bf(hi) << 16); }
__device__ __forceinline__ float bf2f(unsigned b) { return __builtin_bit_cast(float, b << 16); }
__device__ __forceinline__ float bflo(unsigned w) { return __builtin_bit_cast(float, w << 16); }
__device__ __forceinline__ float bfhi(unsigned w) { return __builtin_bit_cast(float, w & 0xffff0000u); }
__device__ __forceinline__ float fast_sigmoid(float x) { return __builtin_amdgcn_rcpf(1.0f + __builtin_amdgcn_exp2f(-1.44269504089f * x)); }
__device__ __forceinline__ float silu_f(float x) { return x * fast_sigmoid(x); }
__device__ __forceinline__ float gelu_f(float x) { const float y = 1.5957691216057308f * x * (1.0f + 0.044715f * x * x); return x * fast_sigmoid(y); }
__device__ __forceinline__ float wave_sum(float v) {
#pragma unroll
    for (int o = 1; o < 64; o <<= 1) v += __shfl_xor(v, o);
    return v;
}

namespace pg8 {
#define PG8_LAS __attribute__((address_space(3)))
typedef unsigned short bf16_t;
typedef short bf16x8 __attribute__((ext_vector_type(8)));
typedef float f32x4 __attribute__((ext_vector_type(4)));
typedef unsigned u32x4 __attribute__((ext_vector_type(4)));
constexpr int BM = 256, BK = 64, HALF = 128, HTB = HALF * BK * 2  , STAGE_BYTES = 8 * HTB, NXCD = 8, WGM = 8;

__host__ __device__ __forceinline__ int lds_byte(int r, int c) { const int st = (r >> 4) * 2 + (c >> 5), rr = r & 15, cc = c & 31, ob = rr * 64 + cc * 2; return st * 1024 + (ob ^ (((ob >> 9) & 1) << 5)); }
__host__ __device__ __forceinline__ void stage_rc(int b, int& R, int& C) { const int st = b / 1024, sb = b % 1024, swz = sb ^ (((sb >> 9) & 1) << 5); R = (st >> 1) * 16 + swz / 64; C = (st & 1) * 32 + (swz % 64) / 2; }
__host__ __device__ __forceinline__ int perm32(int rho) { const int n = rho >> 4, i = rho & 15; return 8 * (i >> 2) + 4 * n + (i & 3); }

struct Unit { int pm, pn; };
struct Gemm { const bf16_t* A; const bf16_t* Bt; int M, N, K; };

struct StaticOrder {
    int nM, nN, nwg, G, c;
    __host__ __device__ void init(int M, int N, int G_, int c_) { nM = M / BM; nN = N / BM; nwg = nM * nN; G = G_; c = c_; }
    __host__ __device__ bool next(int i, Unit& u) const {
        const long L = (long)i * G + c; if (L >= nwg) return false;
        int wgid = (int)L; { const int q = nwg / NXCD, r = nwg % NXCD, xcd = wgid % NXCD, off = wgid / NXCD; wgid = (xcd < r ? xcd * (q + 1) : r * (q + 1) + (xcd - r) * q) + off; }
        const int nig = WGM * nN, gid = wgid / nig, fm = gid * WGM, gsz = (nM - fm) < WGM ? (nM - fm) : WGM;
        u.pm = fm + ((wgid % nig) % gsz); u.pn = (wgid % nig) / gsz; return true;
    }
    __device__ __forceinline__ void a_ready(const Unit&) const {}
    __device__ __forceinline__ void done(const Unit&) const {}
};

__device__ __forceinline__ u32x4 pack8(const f32x4 a, const f32x4 b) { u32x4 w; w.x = pk2(a[0], a[1]); w.y = pk2(a[2], a[3]); w.z = pk2(b[0], b[1]); w.w = pk2(b[2], b[3]); return w; }

struct EpiA1 {
    static constexpr bool PERM = true, AFTER_DRAIN = false;
    bf16_t* UZ; bf16_t* GV; float* ssq;
    __device__ __forceinline__ void operator()(const f32x4 (&acc)[2][2][4][2], const Unit& u, int wr, int wc, int fr, int fq) const {
        const int row0 = u.pm * BM + wr * 64 + fr;
        if (u.pn < 16) {
            const int ch0 = u.pn * 128 + wc * 32 + 8 * fq;
#pragma unroll
            for (int ai = 0; ai < 2; ++ai)
#pragma unroll
                for (int m = 0; m < 4; ++m) {
                    f32x4 r0, r1;
#pragma unroll
                    for (int i = 0; i < 4; ++i) { r0[i] = gelu_f(acc[ai][0][m][0][i]) * silu_f(acc[ai][1][m][0][i]); r1[i] = gelu_f(acc[ai][0][m][1][i]) * silu_f(acc[ai][1][m][1][i]); }
                    *(u32x4*)(UZ + (size_t)(row0 + ai * HALF + m * 16) * DI + ch0) = pack8(r0, r1);
                }
        } else {
            const int j = u.pn - 16, col0 = j * 256 + wc * 32 + 8 * fq;
#pragma unroll
            for (int ai = 0; ai < 2; ++ai)
#pragma unroll
                for (int m = 0; m < 4; ++m) {
                    const int row = row0 + ai * HALF + m * 16; float s = 0.f;
#pragma unroll
                    for (int bj = 0; bj < 2; ++bj) {
                        f32x4 r0, r1;
#pragma unroll
                        for (int i = 0; i < 4; ++i) { r0[i] = gelu_f(acc[ai][bj][m][0][i]); r1[i] = gelu_f(acc[ai][bj][m][1][i]); s += r0[i] * r0[i] + r1[i] * r1[i]; }
                        *(u32x4*)(GV + (size_t)row * DI + col0 + bj * HALF) = pack8(r0, r1);
                    }
                    s += __shfl_xor(s, 16); s += __shfl_xor(s, 32);
                    if (fq == 0) ssq[(size_t)row * 32 + j * 4 + wc] = s;
                }
        }
    }
};

struct EpiB1 {
    static constexpr bool PERM = true, AFTER_DRAIN = false;
    bf16_t* Q; bf16_t* Kk; bf16_t* V; bf16_t* SZ;
    __device__ __forceinline__ void operator()(const f32x4 (&acc)[2][2][4][2], const Unit& u, int wr, int wc, int fr, int fq) const {
        const int row0 = u.pm * BM + wr * 64 + fr, lc = wc * 32 + 8 * fq;
        bf16_t* base; int ld; int mode = 0;
        if (u.pn < 2) { base = Q + u.pn * 256; ld = 512; mode = 1; }
        else if (u.pn < 4) { base = Kk + (u.pn - 2) * 256; ld = 512; }
        else if (u.pn < 12) { base = V + (u.pn - 4) * 256; ld = DI; }
        else { base = SZ + (u.pn - 12) * 256; ld = DI; mode = 2; }
#pragma unroll
        for (int ai = 0; ai < 2; ++ai)
#pragma unroll
            for (int m = 0; m < 4; ++m) {
                bf16_t* rowp = base + (size_t)(row0 + ai * HALF + m * 16) * ld + lc;
#pragma unroll
                for (int bj = 0; bj < 2; ++bj) {
                    f32x4 r0 = acc[ai][bj][m][0], r1 = acc[ai][bj][m][1];
                    if (mode == 1) { r0 = r0 * 0.08838834764831845f; r1 = r1 * 0.08838834764831845f; }
                    else if (mode == 2) {
#pragma unroll
                        for (int i = 0; i < 4; ++i) { r0[i] = silu_f(r0[i]); r1[i] = silu_f(r1[i]); }
                    }
                    *(u32x4*)(rowp + bj * HALF) = pack8(r0, r1);
                }
            }
    }
};

struct EpiOut {
    static constexpr bool PERM = false, AFTER_DRAIN = false;
    const float* Xin; float* Xout; const float* gate;
    __device__ __forceinline__ void operator()(const f32x4 (&acc)[2][2][4][2], const Unit& u, int wr, int wc, int fr, int fq) const {
        const int row0 = u.pm * BM + wr * 64 + fr, col0 = u.pn * BM + wc * 32 + 4 * fq;
        const float* gp = gate + (size_t)(u.pm >> 3) * (3 * D) + col0;
        f32x4 gv[2][2];
#pragma unroll
        for (int bj = 0; bj < 2; ++bj)
#pragma unroll
            for (int n = 0; n < 2; ++n) gv[bj][n] = *(const f32x4*)(gp + bj * HALF + n * 16);
#pragma unroll
        for (int ai = 0; ai < 2; ++ai)
#pragma unroll
            for (int m = 0; m < 4; ++m) {
                const size_t off = (size_t)(row0 + ai * HALF + m * 16) * D + col0;
#pragma unroll
                for (int bj = 0; bj < 2; ++bj)
#pragma unroll
                    for (int n = 0; n < 2; ++n) { const f32x4 xo = *(const f32x4*)(Xin + off + bj * HALF + n * 16); *(f32x4*)(Xout + off + bj * HALF + n * 16) = xo + gv[bj][n] * acc[ai][bj][m][n]; }
            }
    }
};

template <class Epi, class Sched, bool ALIGN_EPI = false, bool SP2 = false>
__device__ __forceinline__ void gemm_phase(PG8_LAS unsigned char* lds, const Gemm g, const Sched& S, const Epi& E) {
    int tid_ = threadIdx.x; asm volatile("" : "+v"(tid_));
    const int tid = tid_, wid = __builtin_amdgcn_readfirstlane(tid >> 6), lane = tid & 63, wr = wid >> 2, wc = wid & 3, fr = lane & 15, fq = lane >> 4;
    const int K = g.K, nt = K / BK;
    unsigned voffA[2], voffB[2];
#pragma unroll
    for (int i = 0; i < 2; ++i) { int R, C; stage_rc(tid * 16 + i * 8192, R, C); const int Rb = Epi::PERM ? ((R & ~31) + perm32(R & 31)) : R;
        voffA[i] = (unsigned)(R * K + C) * 2u; voffB[i] = (unsigned)(Rb * K + C) * 2u; }
    const size_t kstep = (size_t)(BK * 2);
    const size_t hstep = (size_t)HALF * K * 2;
    const size_t tstep = 2 * hstep;
    const unsigned ldsw = (unsigned)wid * 1024u;
    const int aoff = lds_byte(wr * 64 + fr, fq * 8), boff = lds_byte(wc * 32 + fr, fq * 8);
#define PG8_SA(b, h) (((b) * 2 + (h)) * HTB)
#define PG8_SB(b, h) ((4 + (b) * 2 + (h)) * HTB)
#define PG8_STAGE(bufoff, gbase, voff) do { _Pragma("unroll") for (int _i = 0; _i < 2; ++_i) \
        __builtin_amdgcn_global_load_lds((const unsigned*)((const char*)(gbase) + (voff)[_i]), (PG8_LAS unsigned*)(lds + (bufoff) + ldsw + _i * 8192), 16, 0, 0); } while (0)
#define PG8_LDA(dst, b, h) do { _Pragma("unroll") for (int m = 0; m < 4; ++m) _Pragma("unroll") for (int k = 0; k < 2; ++k) dst[m][k] = *(const PG8_LAS bf16x8*)(lds + PG8_SA(b, h) + aoff + m * 2048 + k * 1024); } while (0)
#define PG8_LDB(dst, b, h) do { _Pragma("unroll") for (int n = 0; n < 2; ++n) _Pragma("unroll") for (int k = 0; k < 2; ++k) dst[n][k] = *(const PG8_LAS bf16x8*)(lds + PG8_SB(b, h) + boff + n * 2048 + k * 1024); } while (0)
#define PG8_MMA(ai, bj, At, Bt) do { __builtin_amdgcn_s_setprio(1); _Pragma("unroll") for (int m = 0; m < 4; ++m) _Pragma("unroll") for (int n = 0; n < 2; ++n) _Pragma("unroll") for (int k = 0; k < 2; ++k) \
        acc[ai][bj][m][n] = __builtin_amdgcn_mfma_f32_16x16x32_bf16(Bt[n][k], At[m][k], acc[ai][bj][m][n], 0, 0, 0); __builtin_amdgcn_s_setprio(0); } while (0)
#define PG8_WAIT_V(n) asm volatile("s_waitcnt vmcnt(" #n ")" ::: "memory")
#define PG8_WAIT_L(n) asm volatile("s_waitcnt lgkmcnt(" #n ")" ::: "memory")
#define PG8_BAR __builtin_amdgcn_s_barrier()
#define PG8_SCHED __builtin_amdgcn_sched_barrier(0)
    Unit cur, nxt; int ui = 0;
    if (!S.next(0, cur)) return;
    f32x4 acc[2][2][4][2];
#pragma unroll
    for (int a = 0; a < 2; ++a)
#pragma unroll
        for (int b = 0; b < 2; ++b)
#pragma unroll
            for (int m = 0; m < 4; ++m)
#pragma unroll
                for (int n = 0; n < 2; ++n) acc[a][b][m][n] = (f32x4){0.f, 0.f, 0.f, 0.f};
    bf16x8 At[4][2], B0[2][2], B1[2][2];
    const char* cA = (const char*)g.A + (size_t)cur.pm * tstep; const char* cB = (const char*)g.Bt + (size_t)cur.pn * tstep;
    S.a_ready(cur);
    if constexpr (SP2) {
        PG8_STAGE(PG8_SB(0, 0), cB, voffB); PG8_STAGE(PG8_SB(0, 1), cB + hstep, voffB); PG8_STAGE(PG8_SA(0, 0), cA, voffA); PG8_STAGE(PG8_SA(0, 1), cA + hstep, voffA);
        if (wr == 1) PG8_BAR;
        PG8_WAIT_V(2); PG8_BAR;
        PG8_STAGE(PG8_SB(1, 0), cB + kstep, voffB); PG8_STAGE(PG8_SA(1, 0), cA + kstep, voffA); PG8_STAGE(PG8_SB(1, 1), cB + hstep + kstep, voffB);
        PG8_WAIT_V(6); PG8_BAR;
    } else {
        PG8_STAGE(PG8_SB(0, 0), cB, voffB); PG8_STAGE(PG8_SA(0, 0), cA, voffA); PG8_STAGE(PG8_SB(0, 1), cB + hstep, voffB); PG8_STAGE(PG8_SA(0, 1), cA + hstep, voffA);
        if (wr == 1) PG8_BAR;
        PG8_WAIT_V(4); PG8_BAR;
        PG8_STAGE(PG8_SB(1, 0), cB + kstep, voffB); PG8_STAGE(PG8_SA(1, 0), cA + kstep, voffA); PG8_STAGE(PG8_SB(1, 1), cB + hstep + kstep, voffB);
        PG8_WAIT_V(6); PG8_BAR;
    }
    for (;;) {
        const bool has_next = S.next(ui + 1, nxt);
        const char* nA = has_next ? (const char*)g.A + (size_t)nxt.pm * tstep : cA; const char* nB = has_next ? (const char*)g.Bt + (size_t)nxt.pn * tstep : cB;
        for (int t = 0; t < nt; t += 2) {
            const bool last = (t == nt - 2);
            const char* a1 = cA + (size_t)(t + 1) * kstep;
            const char* a2 = last ? nA : cA + (size_t)(t + 2) * kstep; const char* b2 = last ? nB : cB + (size_t)(t + 2) * kstep;
            const char* a3 = a2 + kstep; const char* b3 = b2 + kstep;
            if (last && has_next) S.a_ready(nxt);
            if constexpr (SP2) {
            PG8_LDB(B0, 0, 0); PG8_LDB(B1, 0, 1); PG8_SCHED; PG8_LDA(At, 0, 0); PG8_STAGE(PG8_SA(1, 1), a1 + hstep, voffA);
            PG8_WAIT_V(8); PG8_WAIT_L(0); PG8_BAR; PG8_MMA(0, 0, At, B0); PG8_MMA(0, 1, At, B1); PG8_BAR; PG8_SCHED;
            PG8_LDA(At, 0, 1); PG8_STAGE(PG8_SB(0, 0), b2, voffB); PG8_STAGE(PG8_SB(0, 1), b2 + hstep, voffB); PG8_STAGE(PG8_SA(0, 0), a2, voffA);
            PG8_WAIT_V(8); PG8_WAIT_L(0); PG8_BAR; PG8_MMA(1, 0, At, B0); PG8_MMA(1, 1, At, B1); PG8_BAR; PG8_SCHED;
            PG8_LDB(B0, 1, 0); PG8_LDB(B1, 1, 1); PG8_SCHED; PG8_LDA(At, 1, 0); PG8_STAGE(PG8_SA(0, 1), a2 + hstep, voffA);
            PG8_WAIT_V(8); PG8_WAIT_L(0); PG8_BAR; PG8_MMA(0, 0, At, B0); PG8_MMA(0, 1, At, B1); PG8_BAR; PG8_SCHED;
            PG8_LDA(At, 1, 1); PG8_STAGE(PG8_SB(1, 0), b3, voffB); PG8_STAGE(PG8_SB(1, 1), b3 + hstep, voffB); PG8_STAGE(PG8_SA(1, 0), a3, voffA);
            PG8_WAIT_V(8); PG8_WAIT_L(0); PG8_BAR; PG8_MMA(1, 0, At, B0); PG8_MMA(1, 1, At, B1); PG8_BAR; PG8_SCHED;
            } else {
            PG8_LDB(B0, 0, 0); PG8_SCHED; PG8_LDA(At, 0, 0); PG8_STAGE(PG8_SA(1, 1), a1 + hstep, voffA);
            PG8_WAIT_L(8); PG8_BAR; PG8_WAIT_L(0); PG8_MMA(0, 0, At, B0); PG8_BAR; PG8_SCHED;
            PG8_LDB(B1, 0, 1); PG8_STAGE(PG8_SB(0, 0), b2, voffB);
            PG8_BAR; PG8_WAIT_L(0); PG8_MMA(0, 1, At, B1); PG8_BAR;
            PG8_LDA(At, 0, 1); PG8_STAGE(PG8_SA(0, 0), a2, voffA);
            PG8_BAR; PG8_WAIT_L(0); PG8_MMA(1, 0, At, B0); PG8_BAR; PG8_SCHED;
            PG8_STAGE(PG8_SB(0, 1), b2 + hstep, voffB);
            PG8_WAIT_V(6); PG8_BAR; PG8_MMA(1, 1, At, B1); PG8_BAR;
            PG8_LDB(B0, 1, 0); PG8_SCHED; PG8_LDA(At, 1, 0); PG8_STAGE(PG8_SA(0, 1), a2 + hstep, voffA);
            PG8_WAIT_L(8); PG8_BAR; PG8_WAIT_L(0); PG8_MMA(0, 0, At, B0); PG8_BAR; PG8_SCHED;
            PG8_LDB(B1, 1, 1); PG8_STAGE(PG8_SB(1, 0), b3, voffB);
            PG8_BAR; PG8_WAIT_L(0); PG8_MMA(0, 1, At, B1); PG8_BAR;
            PG8_LDA(At, 1, 1); PG8_STAGE(PG8_SA(1, 0), a3, voffA);
            PG8_BAR; PG8_WAIT_L(0); PG8_MMA(1, 0, At, B0); PG8_BAR; PG8_SCHED;
            PG8_STAGE(PG8_SB(1, 1), b3 + hstep, voffB);
            PG8_WAIT_V(6); PG8_BAR; PG8_MMA(1, 1, At, B1); PG8_BAR;
            }
        }
        if constexpr (ALIGN_EPI) { if (wr == 0) PG8_BAR; }
        if constexpr (!Epi::AFTER_DRAIN) { E(acc, cur, wr, wc, fr, fq); S.done(cur); }
        if (!has_next) break;
#pragma unroll
        for (int a = 0; a < 2; ++a)
#pragma unroll
            for (int b = 0; b < 2; ++b)
#pragma unroll
                for (int m = 0; m < 4; ++m)
#pragma unroll
                    for (int n = 0; n < 2; ++n) acc[a][b][m][n] = (f32x4){0.f, 0.f, 0.f, 0.f};
        cur = nxt; cA = nA; cB = nB; ++ui;
        if constexpr (ALIGN_EPI) { if (wr == 1) PG8_BAR; }
    }
    PG8_WAIT_V(0);
    if constexpr (!ALIGN_EPI) { if (wr == 0) PG8_BAR; }
    PG8_BAR;
    if constexpr (Epi::AFTER_DRAIN) { E.fused(acc, cur, wr, wc, fr, fq, lds, wid, lane); S.done(cur); }
#undef PG8_SA
#undef PG8_SB
#undef PG8_STAGE
#undef PG8_LDA
#undef PG8_LDB
#undef PG8_MMA
#undef PG8_WAIT_V
#undef PG8_WAIT_L
#undef PG8_BAR
#undef PG8_SCHED
}
}

constexpr size_t KiB = 1024, MiB = 1u << 20;
constexpr size_t WS_CTL = 0, CTL_ZERO_BYTES = 64 * KiB;
constexpr size_t WS_MOD = 64 * KiB;
constexpr size_t WS_ALR = 512 * KiB;
constexpr size_t WS_WAIN = 2 * MiB;
constexpr size_t WS_WAOUT = WS_WAIN + (size_t)2 * A_IN * D * 2;
constexpr size_t WS_WBIN = WS_WAOUT + (size_t)2 * D * DI * 2;
constexpr size_t WS_WBOUT = WS_WBIN + (size_t)2 * B_INW * D * 2;
constexpr size_t WS_WEND = WS_WBOUT + (size_t)2 * D * DI * 2;
constexpr size_t WS_H = 63 * MiB;
constexpr size_t WS_R = 95 * MiB;
constexpr size_t WS_END = 255 * MiB;
static_assert(WS_WEND <= WS_H, "weights overflow");
constexpr size_t WS_UZ = WS_R, WS_GV = WS_R + 64 * MiB, WS_SSQA = WS_R + 128 * MiB;
constexpr size_t WS_Q = WS_R, WS_K = WS_R + 16 * MiB, WS_V = WS_R + 32 * MiB, WS_SZ = WS_R + 96 * MiB;
constexpr size_t WS_SSQB = WS_H;
constexpr size_t WS_DEC = WS_H + 2 * MiB;
constexpr size_t WS_LA = WS_H;
constexpr int CW_BAR = 1024;

constexpr int RING_BYTES = 131072;
constexpr int LDSCTL_OFF = RING_BYTES, MISC_OFF = LDSCTL_OFF + 320;
constexpr int LDS_BYTES = 147456;
constexpr int NWAVES = 8, NTHREADS = 512;

#define LDS_WAIT() asm volatile("s_waitcnt lgkmcnt(0)" ::: "memory")
#define VM_WAIT() asm volatile("s_waitcnt vmcnt(0)" ::: "memory")

#define XB_TMO      128
#define XB_XCNT(j)  (256  + 64 * (j))
#define XB_XSUB(j)  (1280 + 64 * (j))
#define XB_XGEN(j)  (2304 + 64 * (j))
#define XB_TOP      3328
#define XB_TOPGEN   3392
#define XCD_BAR_WORDS 3456
#define XB_SPIN_CAP (1u << 18)

__device__ __forceinline__ unsigned xb_ld(unsigned* p)              { return __hip_atomic_load(p, __ATOMIC_RELAXED, __HIP_MEMORY_SCOPE_AGENT); }
__device__ __forceinline__ unsigned xb_add(unsigned* p, unsigned v) { return __hip_atomic_fetch_add(p, v, __ATOMIC_RELAXED, __HIP_MEMORY_SCOPE_AGENT); }
__device__ __forceinline__ unsigned xb_xcc_id() { return (unsigned)__builtin_amdgcn_s_getreg((3 << 11) | 20) & 0xFu; }
#define XB_SPIN(cond, bar) do { unsigned _sp = 0; while (cond) { __builtin_amdgcn_s_sleep(1); \
    if ((++_sp & 255u) == 0u) { if (xb_ld(&(bar)[XB_TMO])) break; if (_sp > XB_SPIN_CAP) { atomicAdd(&(bar)[XB_TMO], 1u); break; } } } } while (0)

struct XcdBarrier {
    unsigned* bar; unsigned x;
    volatile LAS unsigned* st;
};

__device__ __forceinline__ XcdBarrier xcd_barrier_post(unsigned* bar, volatile LAS unsigned* st) {
    XcdBarrier b; b.bar = bar; b.x = xb_xcc_id(); b.st = st;
    if (threadIdx.x == 0) (void)xb_add(&bar[XB_XCNT(b.x)], 1u);
    return b;
}
__device__ __forceinline__ void xcd_barrier_complete(unsigned* bar, unsigned x, unsigned& nloc, unsigned& nx) {
    const unsigned G = gridDim.x * gridDim.y * gridDim.z;
    unsigned sum, cnt, mine, sp = 0u;
    for (;;) {
        sum = 0u; cnt = 0u; mine = 0u;
#pragma unroll
        for (unsigned j = 0; j < 16; ++j) { const unsigned c = xb_ld(&bar[XB_XCNT(j)]); sum += c; cnt += (c > 0u) ? 1u : 0u; mine = (j == x) ? c : mine; }
        if (sum == G) break;
        __builtin_amdgcn_s_sleep(1);
        if ((++sp & 255u) == 0u) { if (xb_ld(&bar[XB_TMO])) break; if (sp > XB_SPIN_CAP) { atomicAdd(&bar[XB_TMO], 1u); break; } }
    }
    nloc = mine > 0u ? mine : 1u; nx = cnt > 0u ? cnt : 1u;
}

__device__ __forceinline__ void xcd_barrier(const XcdBarrier& b) {
    asm volatile("s_waitcnt vmcnt(0)" ::: "memory");
    __syncthreads();
    if (threadIdx.x == 0) {
        unsigned* bar = b.bar;
        __builtin_amdgcn_s_waitcnt(0);
        unsigned nloc = b.st[0], nx = b.st[1];
        if (nloc == 0u) { xcd_barrier_complete(bar, b.x, nloc, nx); b.st[0] = nloc; b.st[1] = nx; }
        const unsigned old = xb_add(&bar[XB_XSUB(b.x)], 1u);
        const unsigned gen = old / nloc;
        if (old + 1u == (gen + 1u) * nloc) {
            __builtin_amdgcn_fence(__ATOMIC_RELEASE, "agent");
            asm volatile("s_waitcnt vmcnt(0)" ::: "memory");
            const unsigned og = xb_add(&bar[XB_TOP], 1u);
            const unsigned tg = og / nx;
            if (og + 1u == (tg + 1u) * nx) xb_add(&bar[XB_TOPGEN], 1u);
            else XB_SPIN(xb_ld(&bar[XB_TOPGEN]) == tg, bar);
            __builtin_amdgcn_fence(__ATOMIC_ACQUIRE, "agent");
            xb_add(&bar[XB_XGEN(b.x)], 1u);
            asm volatile("s_waitcnt vmcnt(0)" ::: "memory");
        } else {
            XB_SPIN(xb_ld(&bar[XB_XGEN(b.x)]) == gen, bar);
            __builtin_amdgcn_fence(__ATOMIC_ACQUIRE, "agent");
            asm volatile("s_waitcnt vmcnt(0)" ::: "memory");
        }
    }
    __syncthreads();
}


struct Frame {
    LAS unsigned char* lds;
    int tid, lane, wave, vcu, G;
    const float *x, *c, *w_ada, *b_ada, *g_norm, *a_w_in, *a_w_s, *a_b_s, *a_g_v, *a_w_out, *b_w_in, *b_w_gate_up, *b_b_gate, *b_g_o, *b_w_out, *g_final;
    float* out; unsigned char* ws;
};

__device__ __forceinline__ void p0_transpose_item(const float* W, int K, int N, bf16* WT, int k0, int n0, int drow0, LAS float* scr, int lane) {
    const int nn = n0 + (lane & 31); const bool okl = nn < N;
#pragma unroll 8
    for (int i = 0; i < 32; ++i) { const int kk = 2 * i + (lane >> 5); scr[kk * 33 + (lane & 31)] = okl ? W[(size_t)(k0 + kk) * N + nn] : 0.f; }
    LDS_WAIT(); asm volatile("" ::: "memory");
    const int c = lane & 7;
#pragma unroll
    for (int j = 0; j < 4; ++j) { const int n = (lane >> 3) + 8 * j; const LAS float* s = scr + (8 * c) * 33 + n;
        v4u o; o.x = pk2(s[0 * 33], s[1 * 33]); o.y = pk2(s[2 * 33], s[3 * 33]); o.z = pk2(s[4 * 33], s[5 * 33]); o.w = pk2(s[6 * 33], s[7 * 33]);
        if (n0 + n < N) *(GAS v4u*)(WT + (size_t)(drow0 + n) * K + k0 + 8 * c) = o; }
    LDS_WAIT(); asm volatile("" ::: "memory");
}
__device__ __forceinline__ int map_a_in(int c) {
    if (c < DI) return (c >> 7) * 256 + (c & 127);
    if (c < 2 * DI) return 4096 + (c - DI);
    const int cz = c - 2 * DI; return (cz >> 7) * 256 + 128 + (cz & 127);
}
__device__ __forceinline__ void p0_prologue(Frame& F) {
    {
        LAS float* sc = (LAS float*)F.lds;
        LAS float* red = (LAS float*)(F.lds + 32768);
        for (int it = F.vcu; it < 4 * 48; it += F.G) {
            for (int i = F.tid; i < BATCH * D; i += NTHREADS) sc[i] = silu_f(F.c[i]);
            __syncthreads();
            const int l = it / 48, n0 = (it % 48) * 64;
            const float* W = F.w_ada + (size_t)l * D * (3 * D) + n0 + F.lane;
            float acc[8];
#pragma unroll
            for (int b = 0; b < 8; ++b) acc[b] = 0.f;
            const int kb = F.wave * 128;
#pragma unroll 8
            for (int k = 0; k < 128; ++k) { const float w = W[(size_t)(kb + k) * (3 * D)];
#pragma unroll
                for (int b = 0; b < 8; ++b) acc[b] += sc[b * D + kb + k] * w; }
#pragma unroll
            for (int b = 0; b < 8; ++b) red[(F.wave * 8 + b) * 64 + F.lane] = acc[b];
            __syncthreads();
            { const int b = F.tid >> 6, n = F.tid & 63; float s = F.b_ada[l * 3 * D + n0 + n];
#pragma unroll
              for (int w = 0; w < 8; ++w) s += red[(w * 8 + b) * 64 + n];
              ((float*)(F.ws + WS_MOD))[((size_t)l * BATCH + b) * (3 * D) + n0 + n] = s; }
            __syncthreads();
        }
    }
    LAS float* scr = (LAS float*)(F.lds + F.wave * 16384);
    const int gw = F.vcu * NWAVES + F.wave, NGW = F.G * NWAVES;
    constexpr int NB_AIN = A_IN / 32, NB_BIN = (B_INW + 31) / 32, NB_OUT = D / 32;
    constexpr int I_AIN = (D / 64) * NB_AIN, I_AOUT = (DI / 64) * NB_OUT, I_BIN = (D / 64) * NB_BIN, I_BOUT = I_AOUT;
    constexpr int I_LAYER = I_AIN + I_AOUT + I_BIN + I_BOUT;
    for (int it = gw; it < 2 * I_LAYER; it += NGW) {
        const int j = it / I_LAYER; int r = it % I_LAYER;
        if (r < I_AIN) { const int kb = r / NB_AIN, nb = r % NB_AIN;
            p0_transpose_item(F.a_w_in + (size_t)j * D * A_IN, D, A_IN, (bf16*)(F.ws + WS_WAIN) + (size_t)j * A_IN * D, 64 * kb, 32 * nb, map_a_in(32 * nb), scr, F.lane); continue; } r -= I_AIN;
        if (r < I_AOUT) { const int kb = r / NB_OUT, nb = r % NB_OUT;
            p0_transpose_item(F.a_w_out + (size_t)j * DI * D, DI, D, (bf16*)(F.ws + WS_WAOUT) + (size_t)j * D * DI, 64 * kb, 32 * nb, 32 * nb, scr, F.lane); continue; } r -= I_AOUT;
        if (r < I_BIN) { const int kb = r / NB_BIN, nb = r % NB_BIN;
            p0_transpose_item(F.b_w_in + (size_t)j * D * B_INW, D, B_INW, (bf16*)(F.ws + WS_WBIN) + (size_t)j * B_INW * D, 64 * kb, 32 * nb, 32 * nb, scr, F.lane); continue; } r -= I_BIN;
        { const int kb = r / NB_OUT, nb = r % NB_OUT;
            p0_transpose_item(F.b_w_out + (size_t)j * DI * D, DI, D, (bf16*)(F.ws + WS_WBOUT) + (size_t)j * D * DI, 64 * kb, 32 * nb, 32 * nb, scr, F.lane); }
    }
}

__device__ __forceinline__ void h_pass(Frame& F, const float* X, int layer) {
    const int gw = F.vcu * NWAVES + F.wave;
    const int rows_per = M / (F.G * NWAVES);
    const int r0 = gw * rows_per, b = r0 / SEQ;
    const float* mod = (const float*)(F.ws + WS_MOD) + ((size_t)layer * BATCH + b) * (3 * D);
    f32x4 gs[4], sh[4];
#pragma unroll
    for (int j = 0; j < 4; ++j) { const int k = 4 * F.lane + 256 * j; const f32x4 g = *(const f32x4*)(F.g_norm + layer * D + k); const f32x4 sc = *(const f32x4*)(mod + D + k);
        sh[j] = *(const f32x4*)(mod + k); gs[j] = g * (sc + 1.0f); }
    bf16* Hb = (bf16*)(F.ws + WS_H);
    for (int r = r0; r < r0 + rows_per; ++r) {
        const GAS f32x4* xr = (const GAS f32x4*)(X + (size_t)r * D) + F.lane;
        f32x4 v[4]; float s = 0.f;
#pragma unroll
        for (int j = 0; j < 4; ++j) { v[j] = xr[64 * j]; s += (v[j].x * v[j].x + v[j].y * v[j].y) + (v[j].z * v[j].z + v[j].w * v[j].w); }
        const float rinv = 1.0f / sqrtf(wave_sum(s) * (1.f / D) + EPS);
        GAS v2u* o8 = (GAS v2u*)(Hb + (size_t)r * D) + F.lane;
#pragma unroll
        for (int j = 0; j < 4; ++j) { const f32x4 h = v[j] * rinv * gs[j] + sh[j]; v2u w; w.x = pk2(h.x, h.y); w.y = pk2(h.z, h.w); o8[64 * j] = w; }
    }
}
__device__ __forceinline__ void final_norm(Frame& F, float* X) {
    const int gw = F.vcu * NWAVES + F.wave, rows_per = M / (F.G * NWAVES), r0 = gw * rows_per;
    f32x4 g[4];
#pragma unroll
    for (int j = 0; j < 4; ++j) g[j] = *(const f32x4*)(F.g_final + 4 * F.lane + 256 * j);
    for (int r = r0; r < r0 + rows_per; ++r) {
        GAS f32x4* xr = (GAS f32x4*)(X + (size_t)r * D) + F.lane;
        f32x4 v[4]; float s = 0.f;
#pragma unroll
        for (int j = 0; j < 4; ++j) { v[j] = xr[64 * j]; s += (v[j].x * v[j].x + v[j].y * v[j].y) + (v[j].z * v[j].z + v[j].w * v[j].w); }
        const float rinv = 1.0f / sqrtf(wave_sum(s) * (1.f / D) + EPS);
#pragma unroll
        for (int j = 0; j < 4; ++j) xr[64 * j] = v[j] * rinv * g[j];
    }
}

__device__ __forceinline__ void alr_phase(Frame& F, int j) {
    const bf16* Hb = (const bf16*)(F.ws + WS_H);
    const bf16* Wt = (const bf16*)(F.ws + WS_WBIN) + ((size_t)j * B_INW + B_N) * D;
    float* ALR = (float*)(F.ws + WS_ALR);
    LAS f32x4* red = (LAS f32x4*)F.lds;
    const int rows_per = M / F.G;
    const int r0 = F.vcu * rows_per, mt = F.wave & 3, kh = F.wave >> 2, fr = F.lane & 15, fq = F.lane >> 4;
    const bf16* ap = Hb + (size_t)(r0 + mt * 16 + fr) * D + kh * 512 + fq * 8;
    const bf16* bp = Wt + (size_t)fr * D + kh * 512 + fq * 8;
    f32x4 acc = {0.f, 0.f, 0.f, 0.f};
#pragma unroll 4
    for (int ks = 0; ks < 16; ++ks) {
        const bf16x8 a = *(const bf16x8*)(ap + ks * 32), b = *(const bf16x8*)(bp + ks * 32);
        acc = __builtin_amdgcn_mfma_f32_16x16x32_bf16(b, a, acc, 0, 0, 0);
    }
    if (kh == 1) red[mt * 64 + F.lane] = acc;
    __syncthreads();
    if (kh == 0) { acc = acc + red[mt * 64 + F.lane]; *(f32x4*)(ALR + (size_t)(r0 + mt * 16 + fr) * GRANK + 4 * fq) = acc; }
    __syncthreads();
}


#if NAIVE_MIX
__global__ void __launch_bounds__(256) naive_mix(const bf16* GV, bf16* UZ, const float* ssq, const float* w_s, const float* b_s, const float* g_v) {
    __shared__ float rinv[128];
    const int c = blockIdx.x >> 3, g = blockIdx.x & 7, d = threadIdx.x, r0 = c * 128;
    if (d < 128) { float s = 0.f; for (int i = 0; i < 32; ++i) s += ssq[(size_t)(r0 + d) * 32 + i]; rinv[d] = 1.0f / sqrtf(s * (1.f / DI) + EPS); }
    __syncthreads();
    const float gvd = g_v[g * 256 + d];
    for (int t = 0; t < 128; ++t) {
        float acc = 0.f;
        for (int s = 0; s <= t; ++s) acc += w_s[(size_t)(g * 128 + t) * 128 + s] * rinv[s] * bf2f(GV[(size_t)(r0 + s) * DI + g * 256 + d]);
        const float mixed = acc * gvd + b_s[g * 128 + t];
        const size_t idx = (size_t)(r0 + t) * DI + g * 256 + d;
        UZ[idx] = (bf16)f2bf(mixed * bf2f(UZ[idx]));
    }
}
#endif
#if NAIVE_GLA
__global__ void __launch_bounds__(256) naive_la(const float* ALR, const float* wg, const float* bg, float* LA) {
    const size_t idx = (size_t)blockIdx.x * 256 + threadIdx.x; const int row = (int)(idx >> 9), kk = (int)(idx & 511);
    float g = bg[kk];
    for (int i = 0; i < GRANK; ++i) g += ALR[(size_t)row * GRANK + i] * wg[i * 512 + kk];
    const float ls = fminf(g, 0.f) - log1pf(expf(-fabsf(g)));
    LA[idx] = ls * (1.f / 16.f);
}
__global__ void __launch_bounds__(256) naive_scan(const bf16* Q, const bf16* Kk, bf16* V, const float* LA) {
    __shared__ float red[4][64];
    const int b = blockIdx.x >> 5, h = (blockIdx.x >> 3) & 3, vb = blockIdx.x & 7, kq = threadIdx.x >> 6, vv = threadIdx.x & 63;
    float S[32];
#pragma unroll
    for (int i = 0; i < 32; ++i) S[i] = 0.f;
    for (int t = 0; t < SEQ; ++t) {
        const size_t row = (size_t)b * SEQ + t; const size_t vidx = row * DI + h * 512 + vb * 64 + vv;
        const float v = bf2f(V[vidx]); float part = 0.f;
        const size_t kb = row * 512 + h * 128 + kq * 32;
#pragma unroll
        for (int i = 0; i < 32; ++i) { const float a = expf(LA[kb + i]); S[i] = a * S[i] + bf2f(Kk[kb + i]) * v; part += bf2f(Q[kb + i]) * S[i]; }
        red[kq][vv] = part;
        __syncthreads();
        if (kq == 0) V[vidx] = (bf16)f2bf(red[0][vv] + red[1][vv] + red[2][vv] + red[3][vv]);
        __syncthreads();
    }
}
__global__ void __launch_bounds__(256) naive_gla_norm(const bf16* O, bf16* SZ, const float* g_o) {
    const size_t row = blockIdx.x; const int h = threadIdx.x >> 6, l = threadIdx.x & 63;
    float o[8]; float s = 0.f;
#pragma unroll
    for (int i = 0; i < 8; ++i) { o[i] = bf2f(O[row * DI + h * 512 + l * 8 + i]); s += o[i] * o[i]; }
    s = wave_sum(s);
    const float rinv = 1.0f / sqrtf(s * (1.f / GDV) + EPS);
#pragma unroll
    for (int i = 0; i < 8; ++i) { const size_t idx = row * DI + h * 512 + l * 8 + i; SZ[idx] = (bf16)f2bf(o[i] * rinv * g_o[l * 8 + i] * bf2f(SZ[idx])); }
}
#endif
__device__ __forceinline__ void mix_phase(Frame& F, int j) {}
__device__ __forceinline__ void gla_prep_phase(Frame& F, int j) {}
__device__ __forceinline__ void gla_scan_phase(Frame& F, int j) {}
__device__ __forceinline__ void gla_norm_phase(Frame& F) {}

struct Args { const float* in[16]; float* out; unsigned char* ws; int ph_lo, ph_hi, li, pad; };
constexpr int NPH = 2 + 6 * DEPTH;
__host__ __device__ constexpr bool phase_exists(int ph) {
    if (ph < 2) return true;
    const int l = (ph - 2) / 6, k = (ph - 2) % 6;
    if ((l & 1) == 0 && (k == 2 || k == 3)) return false;
    return true;
}

__global__ void __launch_bounds__(NTHREADS, 2) fwd(Args args) {
    extern __shared__ __attribute__((aligned(16))) unsigned char lds[];
    Frame F;
    F.lds = (LAS unsigned char*)lds;
    F.tid = threadIdx.x; F.lane = F.tid & 63; F.wave = __builtin_amdgcn_readfirstlane(F.tid >> 6);
    F.G = gridDim.x; { const int bx = blockIdx.x; F.vcu = (F.G % 8 == 0) ? (bx % 8) * (F.G / 8) + bx / 8 : bx; }
    F.x = args.in[0]; F.c = args.in[1]; F.w_ada = args.in[2]; F.b_ada = args.in[3]; F.g_norm = args.in[4]; F.a_w_in = args.in[5]; F.a_w_s = args.in[6]; F.a_b_s = args.in[7];
    F.a_g_v = args.in[8]; F.a_w_out = args.in[9]; F.b_w_in = args.in[10]; F.b_w_gate_up = args.in[11]; F.b_b_gate = args.in[12]; F.b_g_o = args.in[13]; F.b_w_out = args.in[14]; F.g_final = args.in[15];
    F.out = args.out; F.ws = args.ws;
    volatile LAS unsigned* MISC = (volatile LAS unsigned*)(F.lds + MISC_OFF);
    for (int u = F.tid; u < (LDS_BYTES - LDSCTL_OFF) / 4; u += NTHREADS) ((LAS unsigned*)(F.lds + LDSCTL_OFF))[u] = 0u;
    __syncthreads();
    XcdBarrier bar; bar.bar = (unsigned*)(F.ws + WS_CTL) + CW_BAR; bar.x = 0; bar.st = nullptr;
    const bool multi = (args.ph_hi - args.ph_lo) > 1;
    if (multi) bar = xcd_barrier_post((unsigned*)(F.ws + WS_CTL) + CW_BAR, MISC + 8);

    for (int ph = args.ph_lo; ph < args.ph_hi; ++ph) {
        if (!phase_exists(ph)) continue;
        {
            int t_ = threadIdx.x; asm volatile("" : "+v"(t_)); F.tid = t_; F.lane = t_ & 63; F.wave = __builtin_amdgcn_readfirstlane(t_ >> 6);
            int bx = blockIdx.x; asm volatile("" : "+s"(bx)); F.vcu = (bx % 8) * (F.G / 8) + bx / 8;
            unsigned char* w_ = args.ws; asm volatile("" : "+s"(w_)); F.ws = w_;
        }
        if (ph == 0) p0_prologue(F);
        else if (ph == 1) h_pass(F, F.x, 0);
        else {
            const int l = (ph - 2) / 6, k = (ph - 2) % 6, j = l >> 1; const bool isA = (l & 1) == 0;
            const float* modl = (const float*)(F.ws + WS_MOD) + (size_t)l * BATCH * 3 * D;
            if (k == 0) {
                if (isA) {
                    pg8::Gemm g{(const bf16*)(F.ws + WS_H), (const bf16*)(F.ws + WS_WAIN) + (size_t)j * A_IN * D, M, A_IN, D}; pg8::StaticOrder S; S.init(M, A_IN, F.G, (int)blockIdx.x);
                    pg8::EpiA1 E{(bf16*)(F.ws + WS_UZ), (bf16*)(F.ws + WS_GV), (float*)(F.ws + WS_SSQA)};
                    pg8::gemm_phase<pg8::EpiA1, pg8::StaticOrder, true, true>(F.lds, g, S, E);
                } else {
                    pg8::Gemm g{(const bf16*)(F.ws + WS_H), (const bf16*)(F.ws + WS_WBIN) + (size_t)j * B_INW * D, M, B_N, D}; pg8::StaticOrder S; S.init(M, B_N, F.G, (int)blockIdx.x);
                    pg8::EpiB1 E{(bf16*)(F.ws + WS_Q), (bf16*)(F.ws + WS_K), (bf16*)(F.ws + WS_V), (bf16*)(F.ws + WS_SZ)};
                    pg8::gemm_phase<pg8::EpiB1, pg8::StaticOrder, true, true>(F.lds, g, S, E);
                    alr_phase(F, j);
                }
            } else if (k == 1) {
                if (isA) mix_phase(F, j); else gla_prep_phase(F, j);
            } else if (k == 2) { gla_scan_phase(F, j);
            } else if (k == 3) { gla_norm_phase(F);
            } else if (k == 4) {
                const bf16* A = isA ? (const bf16*)(F.ws + WS_UZ) : (const bf16*)(F.ws + WS_SZ);
                const bf16* Bt = isA ? (const bf16*)(F.ws + WS_WAOUT) + (size_t)j * D * DI : (const bf16*)(F.ws + WS_WBOUT) + (size_t)j * D * DI;
                pg8::Gemm g{A, Bt, M, D, DI}; pg8::StaticOrder S; S.init(M, D, F.G, (int)blockIdx.x);
                pg8::EpiOut E{l == 0 ? F.x : F.out, F.out, modl + 2 * D};
                pg8::gemm_phase<pg8::EpiOut, pg8::StaticOrder, false, true>(F.lds, g, S, E);
            } else {
                if (l + 1 < DEPTH) h_pass(F, F.out, l + 1); else final_norm(F, F.out);
            }
        }
        if (multi && ph + 1 < args.ph_hi) xcd_barrier(bar);
    }
}

extern "C" void kernel_launch(void* const* d_in, const int* in_sizes, int n_in, void* d_out, int out_size, void* d_ws, size_t ws_size, hipStream_t stream) {
    static int grid = 0;
    if (grid == 0) {
        if (n_in != 16 || in_sizes[0] != M * D || out_size != M * D || ws_size < WS_END) { fprintf(stderr, "kernel_launch: unexpected shapes (n_in %d, in0 %d, out %d, ws %zu); nothing launched\n", n_in, n_in > 0 ? in_sizes[0] : -1, out_size, ws_size); grid = -1; return; }
        int dev = 0, cus = 0;
        if (hipGetDevice(&dev) != hipSuccess || hipDeviceGetAttribute(&cus, hipDeviceAttributeMultiprocessorCount, dev) != hipSuccess) { grid = -1; return; }
        if (hipFuncSetAttribute((const void*)fwd, hipFuncAttributeMaxDynamicSharedMemorySize, LDS_BYTES) != hipSuccess) { fprintf(stderr, "kernel_launch: hipFuncSetAttribute failed\n"); grid = -1; return; }
        (void)hipGetLastError();
        grid = cus;
        if (grid != 256) { fprintf(stderr, "kernel_launch: built for 256 CUs, device has %d; nothing launched\n", cus); grid = -1; return; }
    }
    if (grid < 0) return;
    (void)hipMemsetAsync((char*)d_ws + WS_CTL, 0, CTL_ZERO_BYTES, stream);
    Args a{};
    for (int i = 0; i < 16; ++i) a.in[i] = (const float*)d_in[i];
    a.out = (float*)d_out; a.ws = (unsigned char*)d_ws;
#if MK_PER_PHASE
    unsigned char* ws = (unsigned char*)d_ws;
    for (int ph = 0; ph < NPH; ++ph) {
        if (!phase_exists(ph)) continue;
        const int l = ph >= 2 ? (ph - 2) / 6 : -1, k = ph >= 2 ? (ph - 2) % 6 : -1, j = l >> 1; const bool isA = (l & 1) == 0;
        (void)j; (void)isA; (void)k;
#if NAIVE_MIX
        if (l >= 0 && isA && k == 1) {
            naive_mix<<<1024, 256, 0, stream>>>((const bf16*)(ws + WS_GV), (bf16*)(ws + WS_UZ), (const float*)(ws + WS_SSQA), a.in[6] + (size_t)j * SGU_G * SGU_T * SGU_T, a.in[7] + (size_t)j * SGU_G * SGU_T, a.in[8] + (size_t)j * DI);
            continue;
        }
#endif
#if NAIVE_GLA
        if (l >= 0 && !isA && k == 1) { naive_la<<<M * 512 / 256, 256, 0, stream>>>((const float*)(ws + WS_ALR), a.in[11] + (size_t)j * GRANK * 512, a.in[12] + (size_t)j * 512, (float*)(ws + WS_LA)); continue; }
        if (l >= 0 && !isA && k == 2) { naive_scan<<<256, 256, 0, stream>>>((const bf16*)(ws + WS_Q), (const bf16*)(ws + WS_K), (bf16*)(ws + WS_V), (const float*)(ws + WS_LA)); continue; }
        if (l >= 0 && !isA && k == 3) { naive_gla_norm<<<M, 256, 0, stream>>>((const bf16*)(ws + WS_V), (bf16*)(ws + WS_SZ), a.in[13] + (size_t)j * GDV); continue; }
#endif
        a.ph_lo = ph; a.ph_hi = ph + 1; a.li = 0;
        hipLaunchKernelGGL(fwd, dim3(grid), dim3(NTHREADS), LDS_BYTES, stream, a);
    }
#else
    a.ph_lo = 0; a.ph_hi = NPH; a.li = 0;
    hipLaunchKernelGGL(fwd, dim3(grid), dim3(NTHREADS), LDS_BYTES, stream, a);
#endif
    const hipError_t le = hipPeekAtLastError();
    if (le != hipSuccess) fprintf(stderr, "kernel_launch: launch failed: %s\n", hipGetErrorName(le));
}
```

```cpp
#include <hip/hip_runtime.h>
#include <cstdio>
#include <cstdint>

#ifndef MK_PER_PHASE
#define MK_PER_PHASE 0
#endif
#ifndef NAIVE_MIX
#define NAIVE_MIX 0
#endif
#ifndef NAIVE_GLA
#define NAIVE_GLA 0
#endif

constexpr int D = 1024, BATCH = 8, SEQ = 2048, M = BATCH * SEQ, DI = 2048, DEPTH = 4;
constexpr int A_IN = 3 * DI;
constexpr int B_N = 5120, B_INW = 5136;
constexpr int SGU_T = 128, SGU_G = 8, SGU_GD = 256;
constexpr int GH = 4, GDK = 128, GDV = 512, GL = 64, GNC = SEQ / GL, GRANK = 16;
constexpr float EPS = 1e-6f;

#define GAS __attribute__((address_space(1)))
#define LAS __attribute__((address_space(3)))
typedef unsigned short bf16;
typedef unsigned v4u __attribute__((ext_vector_type(4)));
typedef unsigned v2u __attribute__((ext_vector_type(2)));
typedef float f32x4 __attribute__((ext_vector_type(4)));
typedef float f32x2 __attribute__((ext_vector_type(2)));
typedef short bf16x8 __attribute__((ext_vector_type(8)));
typedef short bf16x4 __attribute__((ext_vector_type(4)));

__device__ __forceinline__ unsigned f2bf(float f) { unsigned u = __builtin_bit_cast(unsigned, f); return (u + 0x7fffu + ((u >> 16) & 1u)) >> 16; }
__device__ __forceinline__ unsigned pk2(float lo, float hi) { return f2bf(lo) | (f2bf(hi) << 16); }
__device__ __forceinline__ float bf2f(unsigned b) { return __builtin_bit_cast(float, b << 16); }
__device__ __forceinline__ float bflo(unsigned w) { return __builtin_bit_cast(float, w << 16); }
__device__ __forceinline__ float bfhi(unsigned w) { return __builtin_bit_cast(float, w & 0xffff0000u); }
__device__ __forceinline__ float fast_sigmoid(float x) { return __builtin_amdgcn_rcpf(1.0f + __builtin_amdgcn_exp2f(-1.44269504089f * x)); }
__device__ __forceinline__ float silu_f(float x) { return x * fast_sigmoid(x); }
__device__ __forceinline__ float gelu_f(float x) { const float y = 1.5957691216057308f * x * (1.0f + 0.044715f * x * x); return x * fast_sigmoid(y); }
__device__ __forceinline__ float wave_sum(float v) {
#pragma unroll
    for (int o = 1; o < 64; o <<= 1) v += __shfl_xor(v, o);
    return v;
}

namespace pg8 {
#define PG8_LAS __attribute__((address_space(3)))
typedef unsigned short bf16_t;
typedef short bf16x8 __attribute__((ext_vector_type(8)));
typedef float f32x4 __attribute__((ext_vector_type(4)));
typedef unsigned u32x4 __attribute__((ext_vector_type(4)));
constexpr int BM = 256, BK = 64, HALF = 128, HTB = HALF * BK * 2  , STAGE_BYTES = 8 * HTB, NXCD = 8, WGM = 8;

__host__ __device__ __forceinline__ int lds_byte(int r, int c) { const int st = (r >> 4) * 2 + (c >> 5), rr = r & 15, cc = c & 31, ob = rr * 64 + cc * 2; return st * 1024 + (ob ^ (((ob >> 9) & 1) << 5)); }
__host__ __device__ __forceinline__ void stage_rc(int b, int& R, int& C) { const int st = b / 1024, sb = b % 1024, swz = sb ^ (((sb >> 9) & 1) << 5); R = (st >> 1) * 16 + swz / 64; C = (st & 1) * 32 + (swz % 64) / 2; }
__host__ __device__ __forceinline__ int perm32(int rho) { const int n = rho >> 4, i = rho & 15; return 8 * (i >> 2) + 4 * n + (i & 3); }

struct Unit { int pm, pn; };
struct Gemm { const bf16_t* A; const bf16_t* Bt; int M, N, K; };

struct StaticOrder {
    int nM, nN, nwg, G, c;
    __host__ __device__ void init(int M, int N, int G_, int c_) { nM = M / BM; nN = N / BM; nwg = nM * nN; G = G_; c = c_; }
    __host__ __device__ bool next(int i, Unit& u) const {
        const long L = (long)i * G + c; if (L >= nwg) return false;
        int wgid = (int)L; { const int q = nwg / NXCD, r = nwg % NXCD, xcd = wgid % NXCD, off = wgid / NXCD; wgid = (xcd < r ? xcd * (q + 1) : r * (q + 1) + (xcd - r) * q) + off; }
        const int nig = WGM * nN, gid = wgid / nig, fm = gid * WGM, gsz = (nM - fm) < WGM ? (nM - fm) : WGM;
        u.pm = fm + ((wgid % nig) % gsz); u.pn = (wgid % nig) / gsz; return true;
    }
    __device__ __forceinline__ void a_ready(const Unit&) const {}
    __device__ __forceinline__ void done(const Unit&) const {}
};

__device__ __forceinline__ u32x4 pack8(const f32x4 a, const f32x4 b) { u32x4 w; w.x = pk2(a[0], a[1]); w.y = pk2(a[2], a[3]); w.z = pk2(b[0], b[1]); w.w = pk2(b[2], b[3]); return w; }

struct EpiA1 {
    static constexpr bool PERM = true, AFTER_DRAIN = false;
    bf16_t* UZ; bf16_t* GV; float* ssq;
    __device__ __forceinline__ void operator()(const f32x4 (&acc)[2][2][4][2], const Unit& u, int wr, int wc, int fr, int fq) const {
        const int row0 = u.pm * BM + wr * 64 + fr;
        if (u.pn < 16) {
            const int ch0 = u.pn * 128 + wc * 32 + 8 * fq;
#pragma unroll
            for (int ai = 0; ai < 2; ++ai)
#pragma unroll
                for (int m = 0; m < 4; ++m) {
                    f32x4 r0, r1;
#pragma unroll
                    for (int i = 0; i < 4; ++i) { r0[i] = gelu_f(acc[ai][0][m][0][i]) * silu_f(acc[ai][1][m][0][i]); r1[i] = gelu_f(acc[ai][0][m][1][i]) * silu_f(acc[ai][1][m][1][i]); }
                    *(u32x4*)(UZ + (size_t)(row0 + ai * HALF + m * 16) * DI + ch0) = pack8(r0, r1);
                }
        } else {
            const int j = u.pn - 16, col0 = j * 256 + wc * 32 + 8 * fq;
#pragma unroll
            for (int ai = 0; ai < 2; ++ai)
#pragma unroll
                for (int m = 0; m < 4; ++m) {
                    const int row = row0 + ai * HALF + m * 16; float s = 0.f;
#pragma unroll
                    for (int bj = 0; bj < 2; ++bj) {
                        f32x4 r0, r1;
#pragma unroll
                        for (int i = 0; i < 4; ++i) { r0[i] = gelu_f(acc[ai][bj][m][0][i]); r1[i] = gelu_f(acc[ai][bj][m][1][i]); s += r0[i] * r0[i] + r1[i] * r1[i]; }
                        *(u32x4*)(GV + (size_t)row * DI + col0 + bj * HALF) = pack8(r0, r1);
                    }
                    s += __shfl_xor(s, 16); s += __shfl_xor(s, 32);
                    if (fq == 0) ssq[(size_t)row * 32 + j * 4 + wc] = s;
                }
        }
    }
};

struct EpiB1 {
    static constexpr bool PERM = true, AFTER_DRAIN = false;
    bf16_t* Q; bf16_t* Kk; bf16_t* V; bf16_t* SZ;
    __device__ __forceinline__ void operator()(const f32x4 (&acc)[2][2][4][2], const Unit& u, int wr, int wc, int fr, int fq) const {
        const int row0 = u.pm * BM + wr * 64 + fr, lc = wc * 32 + 8 * fq;
        bf16_t* base; int ld; int mode = 0;
        if (u.pn < 2) { base = Q + u.pn * 256; ld = 512; mode = 1; }
        else if (u.pn < 4) { base = Kk + (u.pn - 2) * 256; ld = 512; }
        else if (u.pn < 12) { base = V + (u.pn - 4) * 256; ld = DI; }
        else { base = SZ + (u.pn - 12) * 256; ld = DI; mode = 2; }
#pragma unroll
        for (int ai = 0; ai < 2; ++ai)
#pragma unroll
            for (int m = 0; m < 4; ++m) {
                bf16_t* rowp = base + (size_t)(row0 + ai * HALF + m * 16) * ld + lc;
#pragma unroll
                for (int bj = 0; bj < 2; ++bj) {
                    f32x4 r0 = acc[ai][bj][m][0], r1 = acc[ai][bj][m][1];
                    if (mode == 1) { r0 = r0 * 0.08838834764831845f; r1 = r1 * 0.08838834764831845f; }
                    else if (mode == 2) {
#pragma unroll
                        for (int i = 0; i < 4; ++i) { r0[i] = silu_f(r0[i]); r1[i] = silu_f(r1[i]); }
                    }
                    *(u32x4*)(rowp + bj * HALF) = pack8(r0, r1);
                }
            }
    }
};

struct EpiOut {
    static constexpr bool PERM = false, AFTER_DRAIN = false;
    const float* Xin; float* Xout; const float* gate;
    __device__ __forceinline__ void operator()(const f32x4 (&acc)[2][2][4][2], const Unit& u, int wr, int wc, int fr, int fq) const {
        const int row0 = u.pm * BM + wr * 64 + fr, col0 = u.pn * BM + wc * 32 + 4 * fq;
        const float* gp = gate + (size_t)(u.pm >> 3) * (3 * D) + col0;
        f32x4 gv[2][2];
#pragma unroll
        for (int bj = 0; bj < 2; ++bj)
#pragma unroll
            for (int n = 0; n < 2; ++n) gv[bj][n] = *(const f32x4*)(gp + bj * HALF + n * 16);
#pragma unroll
        for (int ai = 0; ai < 2; ++ai)
#pragma unroll
            for (int m = 0; m < 4; ++m) {
                const size_t off = (size_t)(row0 + ai * HALF + m * 16) * D + col0;
#pragma unroll
                for (int bj = 0; bj < 2; ++bj)
#pragma unroll
                    for (int n = 0; n < 2; ++n) { const f32x4 xo = *(const f32x4*)(Xin + off + bj * HALF + n * 16); *(f32x4*)(Xout + off + bj * HALF + n * 16) = xo + gv[bj][n] * acc[ai][bj][m][n]; }
            }
    }
};

template <class Epi, class Sched, bool ALIGN_EPI = false, bool SP2 = false>
__device__ __forceinline__ void gemm_phase(PG8_LAS unsigned char* lds, const Gemm g, const Sched& S, const Epi& E) {
    int tid_ = threadIdx.x; asm volatile("" : "+v"(tid_));
    const int tid = tid_, wid = __builtin_amdgcn_readfirstlane(tid >> 6), lane = tid & 63, wr = wid >> 2, wc = wid & 3, fr = lane & 15, fq = lane >> 4;
    const int K = g.K, nt = K / BK;
    unsigned voffA[2], voffB[2];
#pragma unroll
    for (int i = 0; i < 2; ++i) { int R, C; stage_rc(tid * 16 + i * 8192, R, C); const int Rb = Epi::PERM ? ((R & ~31) + perm32(R & 31)) : R;
        voffA[i] = (unsigned)(R * K + C) * 2u; voffB[i] = (unsigned)(Rb * K + C) * 2u; }
    const size_t kstep = (size_t)(BK * 2);
    const size_t hstep = (size_t)HALF * K * 2;
    const size_t tstep = 2 * hstep;
    const unsigned ldsw = (unsigned)wid * 1024u;
    const int aoff = lds_byte(wr * 64 + fr, fq * 8), boff = lds_byte(wc * 32 + fr, fq * 8);
#define PG8_SA(b, h) (((b) * 2 + (h)) * HTB)
#define PG8_SB(b, h) ((4 + (b) * 2 + (h)) * HTB)
#define PG8_STAGE(bufoff, gbase, voff) do { _Pragma("unroll") for (int _i = 0; _i < 2; ++_i) \
        __builtin_amdgcn_global_load_lds((const unsigned*)((const char*)(gbase) + (voff)[_i]), (PG8_LAS unsigned*)(lds + (bufoff) + ldsw + _i * 8192), 16, 0, 0); } while (0)
#define PG8_LDA(dst, b, h) do { _Pragma("unroll") for (int m = 0; m < 4; ++m) _Pragma("unroll") for (int k = 0; k < 2; ++k) dst[m][k] = *(const PG8_LAS bf16x8*)(lds + PG8_SA(b, h) + aoff + m * 2048 + k * 1024); } while (0)
#define PG8_LDB(dst, b, h) do { _Pragma("unroll") for (int n = 0; n < 2; ++n) _Pragma("unroll") for (int k = 0; k < 2; ++k) dst[n][k] = *(const PG8_LAS bf16x8*)(lds + PG8_SB(b, h) + boff + n * 2048 + k * 1024); } while (0)
#define PG8_MMA(ai, bj, At, Bt) do { __builtin_amdgcn_s_setprio(1); _Pragma("unroll") for (int m = 0; m < 4; ++m) _Pragma("unroll") for (int n = 0; n < 2; ++n) _Pragma("unroll") for (int k = 0; k < 2; ++k) \
        acc[ai][bj][m][n] = __builtin_amdgcn_mfma_f32_16x16x32_bf16(Bt[n][k], At[m][k], acc[ai][bj][m][n], 0, 0, 0); __builtin_amdgcn_s_setprio(0); } while (0)
#define PG8_WAIT_V(n) asm volatile("s_waitcnt vmcnt(" #n ")" ::: "memory")
#define PG8_WAIT_L(n) asm volatile("s_waitcnt lgkmcnt(" #n ")" ::: "memory")
#define PG8_BAR __builtin_amdgcn_s_barrier()
#define PG8_SCHED __builtin_amdgcn_sched_barrier(0)
    Unit cur, nxt; int ui = 0;
    if (!S.next(0, cur)) return;
    f32x4 acc[2][2][4][2];
#pragma unroll
    for (int a = 0; a < 2; ++a)
#pragma unroll
        for (int b = 0; b < 2; ++b)
#pragma unroll
            for (int m = 0; m < 4; ++m)
#pragma unroll
                for (int n = 0; n < 2; ++n) acc[a][b][m][n] = (f32x4){0.f, 0.f, 0.f, 0.f};
    bf16x8 At[4][2], B0[2][2], B1[2][2];
    const char* cA = (const char*)g.A + (size_t)cur.pm * tstep; const char* cB = (const char*)g.Bt + (size_t)cur.pn * tstep;
    S.a_ready(cur);
    if constexpr (SP2) {
        PG8_STAGE(PG8_SB(0, 0), cB, voffB); PG8_STAGE(PG8_SB(0, 1), cB + hstep, voffB); PG8_STAGE(PG8_SA(0, 0), cA, voffA); PG8_STAGE(PG8_SA(0, 1), cA + hstep, voffA);
        if (wr == 1) PG8_BAR;
        PG8_WAIT_V(2); PG8_BAR;
        PG8_STAGE(PG8_SB(1, 0), cB + kstep, voffB); PG8_STAGE(PG8_SA(1, 0), cA + kstep, voffA); PG8_STAGE(PG8_SB(1, 1), cB + hstep + kstep, voffB);
        PG8_WAIT_V(6); PG8_BAR;
    } else {
        PG8_STAGE(PG8_SB(0, 0), cB, voffB); PG8_STAGE(PG8_SA(0, 0), cA, voffA); PG8_STAGE(PG8_SB(0, 1), cB + hstep, voffB); PG8_STAGE(PG8_SA(0, 1), cA + hstep, voffA);
        if (wr == 1) PG8_BAR;
        PG8_WAIT_V(4); PG8_BAR;
        PG8_STAGE(PG8_SB(1, 0), cB + kstep, voffB); PG8_STAGE(PG8_SA(1, 0), cA + kstep, voffA); PG8_STAGE(PG8_SB(1, 1), cB + hstep + kstep, voffB);
        PG8_WAIT_V(6); PG8_BAR;
    }
    for (;;) {
        const bool has_next = S.next(ui + 1, nxt);
        const char* nA = has_next ? (const char*)g.A + (size_t)nxt.pm * tstep : cA; const char* nB = has_next ? (const char*)g.Bt + (size_t)nxt.pn * tstep : cB;
        for (int t = 0; t < nt; t += 2) {
            const bool last = (t == nt - 2);
            const char* a1 = cA + (size_t)(t + 1) * kstep;
            const char* a2 = last ? nA : cA + (size_t)(t + 2) * kstep; const char* b2 = last ? nB : cB + (size_t)(t + 2) * kstep;
            const char* a3 = a2 + kstep; const char* b3 = b2 + kstep;
            if (last && has_next) S.a_ready(nxt);
            if constexpr (SP2) {
            PG8_LDB(B0, 0, 0); PG8_LDB(B1, 0, 1); PG8_SCHED; PG8_LDA(At, 0, 0); PG8_STAGE(PG8_SA(1, 1), a1 + hstep, voffA);
            PG8_WAIT_V(8); PG8_WAIT_L(0); PG8_BAR; PG8_MMA(0, 0, At, B0); PG8_MMA(0, 1, At, B1); PG8_BAR; PG8_SCHED;
            PG8_LDA(At, 0, 1); PG8_STAGE(PG8_SB(0, 0), b2, voffB); PG8_STAGE(PG8_SB(0, 1), b2 + hstep, voffB); PG8_STAGE(PG8_SA(0, 0), a2, voffA);
            PG8_WAIT_V(8); PG8_WAIT_L(0); PG8_BAR; PG8_MMA(1, 0, At, B0); PG8_MMA(1, 1, At, B1); PG8_BAR; PG8_SCHED;
            PG8_LDB(B0, 1, 0); PG8_LDB(B1, 1, 1); PG8_SCHED; PG8_LDA(At, 1, 0); PG8_STAGE(PG8_SA(0, 1), a2 + hstep, voffA);
            PG8_WAIT_V(8); PG8_WAIT_L(0); PG8_BAR; PG8_MMA(0, 0, At, B0); PG8_MMA(0, 1, At, B1); PG8_BAR; PG8_SCHED;
            PG8_LDA(At, 1, 1); PG8_STAGE(PG8_SB(1, 0), b3, voffB); PG8_STAGE(PG8_SB(1, 1), b3 + hstep, voffB); PG8_STAGE(PG8_SA(1, 0), a3, voffA);
            PG8_WAIT_V(8); PG8_WAIT_L(0); PG8_BAR; PG8_MMA(1, 0, At, B0); PG8_MMA(1, 1, At, B1); PG8_BAR; PG8_SCHED;
            } else {
            PG8_LDB(B0, 0, 0); PG8_SCHED; PG8_LDA(At, 0, 0); PG8_STAGE(PG8_SA(1, 1), a1 + hstep, voffA);
            PG8_WAIT_L(8); PG8_BAR; PG8_WAIT_L(0); PG8_MMA(0, 0, At, B0); PG8_BAR; PG8_SCHED;
            PG8_LDB(B1, 0, 1); PG8_STAGE(PG8_SB(0, 0), b2, voffB);
            PG8_BAR; PG8_WAIT_L(0); PG8_MMA(0, 1, At, B1); PG8_BAR;
            PG8_LDA(At, 0, 1); PG8_STAGE(PG8_SA(0, 0), a2, voffA);
            PG8_BAR; PG8_WAIT_L(0); PG8_MMA(1, 0, At, B0); PG8_BAR; PG8_SCHED;
            PG8_STAGE(PG8_SB(0, 1), b2 + hstep, voffB);
            PG8_WAIT_V(6); PG8_BAR; PG8_MMA(1, 1, At, B1); PG8_BAR;
            PG8_LDB(B0, 1, 0); PG8_SCHED; PG8_LDA(At, 1, 0); PG8_STAGE(PG8_SA(0, 1), a2 + hstep, voffA);
            PG8_WAIT_L(8); PG8_BAR; PG8_WAIT_L(0); PG8_MMA(0, 0, At, B0); PG8_BAR; PG8_SCHED;
            PG8_LDB(B1, 1, 1); PG8_STAGE(PG8_SB(1, 0), b3, voffB);
            PG8_BAR; PG8_WAIT_L(0); PG8_MMA(0, 1, At, B1); PG8_BAR;
            PG8_LDA(At, 1, 1); PG8_STAGE(PG8_SA(1, 0), a3, voffA);
            PG8_BAR; PG8_WAIT_L(0); PG8_MMA(1, 0, At, B0); PG8_BAR; PG8_SCHED;
            PG8_STAGE(PG8_SB(1, 1), b3 + hstep, voffB);
            PG8_WAIT_V(6); PG8_BAR; PG8_MMA(1, 1, At, B1); PG8_BAR;
            }
        }
        if constexpr (ALIGN_EPI) { if (wr == 0) PG8_BAR; }
        if constexpr (!Epi::AFTER_DRAIN) { E(acc, cur, wr, wc, fr, fq); S.done(cur); }
        if (!has_next) break;
#pragma unroll
        for (int a = 0; a < 2; ++a)
#pragma unroll
            for (int b = 0; b < 2; ++b)
#pragma unroll
                for (int m = 0; m < 4; ++m)
#pragma unroll
                    for (int n = 0; n < 2; ++n) acc[a][b][m][n] = (f32x4){0.f, 0.f, 0.f, 0.f};
        cur = nxt; cA = nA; cB = nB; ++ui;
        if constexpr (ALIGN_EPI) { if (wr == 1) PG8_BAR; }
    }
    PG8_WAIT_V(0);
    if constexpr (!ALIGN_EPI) { if (wr == 0) PG8_BAR; }
    PG8_BAR;
    if constexpr (Epi::AFTER_DRAIN) { E.fused(acc, cur, wr, wc, fr, fq, lds, wid, lane); S.done(cur); }
#undef PG8_SA
#undef PG8_SB
#undef PG8_STAGE
#undef PG8_LDA
#undef PG8_LDB
#undef PG8_MMA
#undef PG8_WAIT_V
#undef PG8_WAIT_L
#undef PG8_BAR
#undef PG8_SCHED
}
}

constexpr size_t KiB = 1024, MiB = 1u << 20;
constexpr size_t WS_CTL = 0, CTL_ZERO_BYTES = 64 * KiB;
constexpr size_t WS_MOD = 64 * KiB;
constexpr size_t WS_ALR = 512 * KiB;
constexpr size_t WS_WAIN = 2 * MiB;
constexpr size_t WS_WAOUT = WS_WAIN + (size_t)2 * A_IN * D * 2;
constexpr size_t WS_WBIN = WS_WAOUT + (size_t)2 * D * DI * 2;
constexpr size_t WS_WBOUT = WS_WBIN + (size_t)2 * B_INW * D * 2;
constexpr size_t WS_WEND = WS_WBOUT + (size_t)2 * D * DI * 2;
constexpr size_t WS_H = 63 * MiB;
constexpr size_t WS_R = 95 * MiB;
constexpr size_t WS_END = 255 * MiB;
static_assert(WS_WEND <= WS_H, "weights overflow");
constexpr size_t WS_UZ = WS_R, WS_GV = WS_R + 64 * MiB, WS_SSQA = WS_R + 128 * MiB;
constexpr size_t WS_Q = WS_R, WS_K = WS_R + 16 * MiB, WS_V = WS_R + 32 * MiB, WS_SZ = WS_R + 96 * MiB;
constexpr size_t WS_SSQB = WS_H;
constexpr size_t WS_DEC = WS_H + 2 * MiB;
constexpr size_t WS_LA = WS_H;
constexpr int CW_BAR = 1024;

constexpr int RING_BYTES = 131072;
constexpr int LDSCTL_OFF = RING_BYTES, MISC_OFF = LDSCTL_OFF + 320;
constexpr int LDS_BYTES = 147456;
constexpr int NWAVES = 8, NTHREADS = 512;

#define LDS_WAIT() asm volatile("s_waitcnt lgkmcnt(0)" ::: "memory")
#define VM_WAIT() asm volatile("s_waitcnt vmcnt(0)" ::: "memory")

#define XB_TMO      128
#define XB_XCNT(j)  (256  + 64 * (j))
#define XB_XSUB(j)  (1280 + 64 * (j))
#define XB_XGEN(j)  (2304 + 64 * (j))
#define XB_TOP      3328
#define XB_TOPGEN   3392
#define XCD_BAR_WORDS 3456
#define XB_SPIN_CAP (1u << 18)

__device__ __forceinline__ unsigned xb_ld(unsigned* p)              { return __hip_atomic_load(p, __ATOMIC_RELAXED, __HIP_MEMORY_SCOPE_AGENT); }
__device__ __forceinline__ unsigned xb_add(unsigned* p, unsigned v) { return __hip_atomic_fetch_add(p, v, __ATOMIC_RELAXED, __HIP_MEMORY_SCOPE_AGENT); }
__device__ __forceinline__ unsigned xb_xcc_id() { return (unsigned)__builtin_amdgcn_s_getreg((3 << 11) | 20) & 0xFu; }
#define XB_SPIN(cond, bar) do { unsigned _sp = 0; while (cond) { __builtin_amdgcn_s_sleep(1); \
    if ((++_sp & 255u) == 0u) { if (xb_ld(&(bar)[XB_TMO])) break; if (_sp > XB_SPIN_CAP) { atomicAdd(&(bar)[XB_TMO], 1u); break; } } } } while (0)

struct XcdBarrier {
    unsigned* bar; unsigned x;
    volatile LAS unsigned* st;
};

__device__ __forceinline__ XcdBarrier xcd_barrier_post(unsigned* bar, volatile LAS unsigned* st) {
    XcdBarrier b; b.bar = bar; b.x = xb_xcc_id(); b.st = st;
    if (threadIdx.x == 0) (void)xb_add(&bar[XB_XCNT(b.x)], 1u);
    return b;
}
__device__ __forceinline__ void xcd_barrier_complete(unsigned* bar, unsigned x, unsigned& nloc, unsigned& nx) {
    const unsigned G = gridDim.x * gridDim.y * gridDim.z;
    unsigned sum, cnt, mine, sp = 0u;
    for (;;) {
        sum = 0u; cnt = 0u; mine = 0u;
#pragma unroll
        for (unsigned j = 0; j < 16; ++j) { const unsigned c = xb_ld(&bar[XB_XCNT(j)]); sum += c; cnt += (c > 0u) ? 1u : 0u; mine = (j == x) ? c : mine; }
        if (sum == G) break;
        __builtin_amdgcn_s_sleep(1);
        if ((++sp & 255u) == 0u) { if (xb_ld(&bar[XB_TMO])) break; if (sp > XB_SPIN_CAP) { atomicAdd(&bar[XB_TMO], 1u); break; } }
    }
    nloc = mine > 0u ? mine : 1u; nx = cnt > 0u ? cnt : 1u;
}

__device__ __forceinline__ void xcd_barrier(const XcdBarrier& b) {
    asm volatile("s_waitcnt vmcnt(0)" ::: "memory");
    __syncthreads();
    if (threadIdx.x == 0) {
        unsigned* bar = b.bar;
        __builtin_amdgcn_s_waitcnt(0);
        unsigned nloc = b.st[0], nx = b.st[1];
        if (nloc == 0u) { xcd_barrier_complete(bar, b.x, nloc, nx); b.st[0] = nloc; b.st[1] = nx; }
        const unsigned old = xb_add(&bar[XB_XSUB(b.x)], 1u);
        const unsigned gen = old / nloc;
        if (old + 1u == (gen + 1u) * nloc) {
            __builtin_amdgcn_fence(__ATOMIC_RELEASE, "agent");
            asm volatile("s_waitcnt vmcnt(0)" ::: "memory");
            const unsigned og = xb_add(&bar[XB_TOP], 1u);
            const unsigned tg = og / nx;
            if (og + 1u == (tg + 1u) * nx) xb_add(&bar[XB_TOPGEN], 1u);
            else XB_SPIN(xb_ld(&bar[XB_TOPGEN]) == tg, bar);
            __builtin_amdgcn_fence(__ATOMIC_ACQUIRE, "agent");
            xb_add(&bar[XB_XGEN(b.x)], 1u);
            asm volatile("s_waitcnt vmcnt(0)" ::: "memory");
        } else {
            XB_SPIN(xb_ld(&bar[XB_XGEN(b.x)]) == gen, bar);
            __builtin_amdgcn_fence(__ATOMIC_ACQUIRE, "agent");
            asm volatile("s_waitcnt vmcnt(0)" ::: "memory");
        }
    }
    __syncthreads();
}


struct Frame {
    LAS unsigned char* lds;
    int tid, lane, wave, vcu, G;
    const float *x, *c, *w_ada, *b_ada, *g_norm, *a_w_in, *a_w_s, *a_b_s, *a_g_v, *a_w_out, *b_w_in, *b_w_gate_up, *b_b_gate, *b_g_o, *b_w_out, *g_final;
    float* out; unsigned char* ws;
};

__device__ __forceinline__ void p0_transpose_item(const float* W, int K, int N, bf16* WT, int k0, int n0, int drow0, LAS float* scr, int lane) {
    const int nn = n0 + (lane & 31); const bool okl = nn < N;
#pragma unroll 8
    for (int i = 0; i < 32; ++i) { const int kk = 2 * i + (lane >> 5); scr[kk * 33 + (lane & 31)] = okl ? W[(size_t)(k0 + kk) * N + nn] : 0.f; }
    LDS_WAIT(); asm volatile("" ::: "memory");
    const int c = lane & 7;
#pragma unroll
    for (int j = 0; j < 4; ++j) { const int n = (lane >> 3) + 8 * j; const LAS float* s = scr + (8 * c) * 33 + n;
        v4u o; o.x = pk2(s[0 * 33], s[1 * 33]); o.y = pk2(s[2 * 33], s[3 * 33]); o.z = pk2(s[4 * 33], s[5 * 33]); o.w = pk2(s[6 * 33], s[7 * 33]);
        if (n0 + n < N) *(GAS v4u*)(WT + (size_t)(drow0 + n) * K + k0 + 8 * c) = o; }
    LDS_WAIT(); asm volatile("" ::: "memory");
}
__device__ __forceinline__ int map_a_in(int c) {
    if (c < DI) return (c >> 7) * 256 + (c & 127);
    if (c < 2 * DI) return 4096 + (c - DI);
    const int cz = c - 2 * DI; return (cz >> 7) * 256 + 128 + (cz & 127);
}
__device__ __forceinline__ void p0_prologue(Frame& F) {
    {
        LAS float* sc = (LAS float*)F.lds;
        LAS float* red = (LAS float*)(F.lds + 32768);
        for (int it = F.vcu; it < 4 * 48; it += F.G) {
            for (int i = F.tid; i < BATCH * D; i += NTHREADS) sc[i] = silu_f(F.c[i]);
            __syncthreads();
            const int l = it / 48, n0 = (it % 48) * 64;
            const float* W = F.w_ada + (size_t)l * D * (3 * D) + n0 + F.lane;
            float acc[8];
#pragma unroll
            for (int b = 0; b < 8; ++b) acc[b] = 0.f;
            const int kb = F.wave * 128;
#pragma unroll 8
            for (int k = 0; k < 128; ++k) { const float w = W[(size_t)(kb + k) * (3 * D)];
#pragma unroll
                for (int b = 0; b < 8; ++b) acc[b] += sc[b * D + kb + k] * w; }
#pragma unroll
            for (int b = 0; b < 8; ++b) red[(F.wave * 8 + b) * 64 + F.lane] = acc[b];
            __syncthreads();
            { const int b = F.tid >> 6, n = F.tid & 63; float s = F.b_ada[l * 3 * D + n0 + n];
#pragma unroll
              for (int w = 0; w < 8; ++w) s += red[(w * 8 + b) * 64 + n];
              ((float*)(F.ws + WS_MOD))[((size_t)l * BATCH + b) * (3 * D) + n0 + n] = s; }
            __syncthreads();
        }
    }
    LAS float* scr = (LAS float*)(F.lds + F.wave * 16384);
    const int gw = F.vcu * NWAVES + F.wave, NGW = F.G * NWAVES;
    constexpr int NB_AIN = A_IN / 32, NB_BIN = (B_INW + 31) / 32, NB_OUT = D / 32;
    constexpr int I_AIN = (D / 64) * NB_AIN, I_AOUT = (DI / 64) * NB_OUT, I_BIN = (D / 64) * NB_BIN, I_BOUT = I_AOUT;
    constexpr int I_LAYER = I_AIN + I_AOUT + I_BIN + I_BOUT;
    for (int it = gw; it < 2 * I_LAYER; it += NGW) {
        const int j = it / I_LAYER; int r = it % I_LAYER;
        if (r < I_AIN) { const int kb = r / NB_AIN, nb = r % NB_AIN;
            p0_transpose_item(F.a_w_in + (size_t)j * D * A_IN, D, A_IN, (bf16*)(F.ws + WS_WAIN) + (size_t)j * A_IN * D, 64 * kb, 32 * nb, map_a_in(32 * nb), scr, F.lane); continue; } r -= I_AIN;
        if (r < I_AOUT) { const int kb = r / NB_OUT, nb = r % NB_OUT;
            p0_transpose_item(F.a_w_out + (size_t)j * DI * D, DI, D, (bf16*)(F.ws + WS_WAOUT) + (size_t)j * D * DI, 64 * kb, 32 * nb, 32 * nb, scr, F.lane); continue; } r -= I_AOUT;
        if (r < I_BIN) { const int kb = r / NB_BIN, nb = r % NB_BIN;
            p0_transpose_item(F.b_w_in + (size_t)j * D * B_INW, D, B_INW, (bf16*)(F.ws + WS_WBIN) + (size_t)j * B_INW * D, 64 * kb, 32 * nb, 32 * nb, scr, F.lane); continue; } r -= I_BIN;
        { const int kb = r / NB_OUT, nb = r % NB_OUT;
            p0_transpose_item(F.b_w_out + (size_t)j * DI * D, DI, D, (bf16*)(F.ws + WS_WBOUT) + (size_t)j * D * DI, 64 * kb, 32 * nb, 32 * nb, scr, F.lane); }
    }
}

__device__ __forceinline__ void h_pass(Frame& F, const float* X, int layer) {
    const int gw = F.vcu * NWAVES + F.wave;
    const int rows_per = M / (F.G * NWAVES);
    const int r0 = gw * rows_per, b = r0 / SEQ;
    const float* mod = (const float*)(F.ws + WS_MOD) + ((size_t)layer * BATCH + b) * (3 * D);
    f32x4 gs[4], sh[4];
#pragma unroll
    for (int j = 0; j < 4; ++j) { const int k = 4 * F.lane + 256 * j; const f32x4 g = *(const f32x4*)(F.g_norm + layer * D + k); const f32x4 sc = *(const f32x4*)(mod + D + k);
        sh[j] = *(const f32x4*)(mod + k); gs[j] = g * (sc + 1.0f); }
    bf16* Hb = (bf16*)(F.ws + WS_H);
    for (int r = r0; r < r0 + rows_per; ++r) {
        const GAS f32x4* xr = (const GAS f32x4*)(X + (size_t)r * D) + F.lane;
        f32x4 v[4]; float s = 0.f;
#pragma unroll
        for (int j = 0; j < 4; ++j) { v[j] = xr[64 * j]; s += (v[j].x * v[j].x + v[j].y * v[j].y) + (v[j].z * v[j].z + v[j].w * v[j].w); }
        const float rinv = 1.0f / sqrtf(wave_sum(s) * (1.f / D) + EPS);
        GAS v2u* o8 = (GAS v2u*)(Hb + (size_t)r * D) + F.lane;
#pragma unroll
        for (int j = 0; j < 4; ++j) { const f32x4 h = v[j] * rinv * gs[j] + sh[j]; v2u w; w.x = pk2(h.x, h.y); w.y = pk2(h.z, h.w); o8[64 * j] = w; }
    }
}
__device__ __forceinline__ void final_norm(Frame& F, float* X) {
    const int gw = F.vcu * NWAVES + F.wave, rows_per = M / (F.G * NWAVES), r0 = gw * rows_per;
    f32x4 g[4];
#pragma unroll
    for (int j = 0; j < 4; ++j) g[j] = *(const f32x4*)(F.g_final + 4 * F.lane + 256 * j);
    for (int r = r0; r < r0 + rows_per; ++r) {
        GAS f32x4* xr = (GAS f32x4*)(X + (size_t)r * D) + F.lane;
        f32x4 v[4]; float s = 0.f;
#pragma unroll
        for (int j = 0; j < 4; ++j) { v[j] = xr[64 * j]; s += (v[j].x * v[j].x + v[j].y * v[j].y) + (v[j].z * v[j].z + v[j].w * v[j].w); }
        const float rinv = 1.0f / sqrtf(wave_sum(s) * (1.f / D) + EPS);
#pragma unroll
        for (int j = 0; j < 4; ++j) xr[64 * j] = v[j] * rinv * g[j];
    }
}

__device__ __forceinline__ void alr_phase(Frame& F, int j) {
    const bf16* Hb = (const bf16*)(F.ws + WS_H);
    const bf16* Wt = (const bf16*)(F.ws + WS_WBIN) + ((size_t)j * B_INW + B_N) * D;
    float* ALR = (float*)(F.ws + WS_ALR);
    LAS f32x4* red = (LAS f32x4*)F.lds;
    const int rows_per = M / F.G;
    const int r0 = F.vcu * rows_per, mt = F.wave & 3, kh = F.wave >> 2, fr = F.lane & 15, fq = F.lane >> 4;
    const bf16* ap = Hb + (size_t)(r0 + mt * 16 + fr) * D + kh * 512 + fq * 8;
    const bf16* bp = Wt + (size_t)fr * D + kh * 512 + fq * 8;
    f32x4 acc = {0.f, 0.f, 0.f, 0.f};
#pragma unroll 4
    for (int ks = 0; ks < 16; ++ks) {
        const bf16x8 a = *(const bf16x8*)(ap + ks * 32), b = *(const bf16x8*)(bp + ks * 32);
        acc = __builtin_amdgcn_mfma_f32_16x16x32_bf16(b, a, acc, 0, 0, 0);
    }
    if (kh == 1) red[mt * 64 + F.lane] = acc;
    __syncthreads();
    if (kh == 0) { acc = acc + red[mt * 64 + F.lane]; *(f32x4*)(ALR + (size_t)(r0 + mt * 16 + fr) * GRANK + 4 * fq) = acc; }
    __syncthreads();
}


#if NAIVE_MIX
__global__ void __launch_bounds__(256) naive_mix(const bf16* GV, bf16* UZ, const float* ssq, const float* w_s, const float* b_s, const float* g_v) {
    __shared__ float rinv[128];
    const int c = blockIdx.x >> 3, g = blockIdx.x & 7, d = threadIdx.x, r0 = c * 128;
    if (d < 128) { float s = 0.f; for (int i = 0; i < 32; ++i) s += ssq[(size_t)(r0 + d) * 32 + i]; rinv[d] = 1.0f / sqrtf(s * (1.f / DI) + EPS); }
    __syncthreads();
    const float gvd = g_v[g * 256 + d];
    for (int t = 0; t < 128; ++t) {
        float acc = 0.f;
        for (int s = 0; s <= t; ++s) acc += w_s[(size_t)(g * 128 + t) * 128 + s] * rinv[s] * bf2f(GV[(size_t)(r0 + s) * DI + g * 256 + d]);
        const float mixed = acc * gvd + b_s[g * 128 + t];
        const size_t idx = (size_t)(r0 + t) * DI + g * 256 + d;
        UZ[idx] = (bf16)f2bf(mixed * bf2f(UZ[idx]));
    }
}
#endif
#if NAIVE_GLA
__global__ void __launch_bounds__(256) naive_la(const float* ALR, const float* wg, const float* bg, float* LA) {
    const size_t idx = (size_t)blockIdx.x * 256 + threadIdx.x; const int row = (int)(idx >> 9), kk = (int)(idx & 511);
    float g = bg[kk];
    for (int i = 0; i < GRANK; ++i) g += ALR[(size_t)row * GRANK + i] * wg[i * 512 + kk];
    const float ls = fminf(g, 0.f) - log1pf(expf(-fabsf(g)));
    LA[idx] = ls * (1.f / 16.f);
}
__global__ void __launch_bounds__(256) naive_scan(const bf16* Q, const bf16* Kk, bf16* V, const float* LA) {
    __shared__ float red[4][64];
    const int b = blockIdx.x >> 5, h = (blockIdx.x >> 3) & 3, vb = blockIdx.x & 7, kq = threadIdx.x >> 6, vv = threadIdx.x & 63;
    float S[32];
#pragma unroll
    for (int i = 0; i < 32; ++i) S[i] = 0.f;
    for (int t = 0; t < SEQ; ++t) {
        const size_t row = (size_t)b * SEQ + t; const size_t vidx = row * DI + h * 512 + vb * 64 + vv;
        const float v = bf2f(V[vidx]); float part = 0.f;
        const size_t kb = row * 512 + h * 128 + kq * 32;
#pragma unroll
        for (int i = 0; i < 32; ++i) { const float a = expf(LA[kb + i]); S[i] = a * S[i] + bf2f(Kk[kb + i]) * v; part += bf2f(Q[kb + i]) * S[i]; }
        red[kq][vv] = part;
        __syncthreads();
        if (kq == 0) V[vidx] = (bf16)f2bf(red[0][vv] + red[1][vv] + red[2][vv] + red[3][vv]);
        __syncthreads();
    }
}
__global__ void __launch_bounds__(256) naive_gla_norm(const bf16* O, bf16* SZ, const float* g_o) {
    const size_t row = blockIdx.x; const int h = threadIdx.x >> 6, l = threadIdx.x & 63;
    float o[8]; float s = 0.f;
#pragma unroll
    for (int i = 0; i < 8; ++i) { o[i] = bf2f(O[row * DI + h * 512 + l * 8 + i]); s += o[i] * o[i]; }
    s = wave_sum(s);
    const float rinv = 1.0f / sqrtf(s * (1.f / GDV) + EPS);
#pragma unroll
    for (int i = 0; i < 8; ++i) { const size_t idx = row * DI + h * 512 + l * 8 + i; SZ[idx] = (bf16)f2bf(o[i] * rinv * g_o[l * 8 + i] * bf2f(SZ[idx])); }
}
#endif

typedef short s16x4 __attribute__((ext_vector_type(4)));
__device__ __forceinline__ bf16x8 cat4(s16x4 a, s16x4 b) { return __builtin_shufflevector(a, b, 0, 1, 2, 3, 4, 5, 6, 7); }
__device__ __forceinline__ unsigned lds_u32(const LAS unsigned char* p) { return (unsigned)(uintptr_t)p; }
template <int O0, int O1, int O2, int O3>
__device__ __forceinline__ void tr4(unsigned base, s16x4& r0, s16x4& r1, s16x4& r2, s16x4& r3) {
    asm volatile("ds_read_b64_tr_b16 %0, %4 offset:%5\n\tds_read_b64_tr_b16 %1, %4 offset:%6\n\tds_read_b64_tr_b16 %2, %4 offset:%7\n\tds_read_b64_tr_b16 %3, %4 offset:%8\n\ts_waitcnt lgkmcnt(0)"
                 : "=&v"(r0), "=&v"(r1), "=&v"(r2), "=&v"(r3) : "v"(base), "i"(O0), "i"(O1), "i"(O2), "i"(O3) : "memory");
}
__device__ __forceinline__ f32x4 unpk_lo(v2u w) { return (f32x4){bflo(w.x), bfhi(w.x), bflo(w.y), bfhi(w.y)}; }

constexpr int MX_WSTR = 272, MX_GSTR = 576, MX_WM = 0, MX_GV = 128 * MX_WSTR, MX_RINV = MX_GV + 128 * MX_GSTR;
static_assert(MX_RINV + 512 <= RING_BYTES, "mix LDS");
template <int KS>
__device__ __forceinline__ void mix_kstep(const LAS unsigned char* lds, unsigned trbase, int fr, int fq, f32x4 (&acc)[2][8]) {
    s16x4 a00, a01, a10, a11;
    tr4<KS * 32 * MX_GSTR, KS * 32 * MX_GSTR + 4 * MX_GSTR, KS * 32 * MX_GSTR + 8, KS * 32 * MX_GSTR + 4 * MX_GSTR + 8>(trbase, a00, a01, a10, a11);
    __builtin_amdgcn_sched_barrier(0);
    const bf16x8 A0 = cat4(a00, a01), A1 = cat4(a10, a11);
#pragma unroll
    for (int tt = 0; tt < 8; ++tt) {
        if (2 * KS <= tt) {
            const bf16x8 B = *(const LAS bf16x8*)(lds + MX_WM + (16 * tt + fr) * MX_WSTR + 64 * KS + 16 * fq);
            acc[0][tt] = __builtin_amdgcn_mfma_f32_16x16x32_bf16(A0, B, acc[0][tt], 0, 0, 0);
            acc[1][tt] = __builtin_amdgcn_mfma_f32_16x16x32_bf16(A1, B, acc[1][tt], 0, 0, 0);
        }
    }
}
__device__ __forceinline__ void mix_phase(Frame& F, int j) {
    const bf16* GV = (const bf16*)(F.ws + WS_GV); bf16* UZ = (bf16*)(F.ws + WS_UZ); const float* ssq = (const float*)(F.ws + WS_SSQA);
    const float* w_s = F.a_w_s + (size_t)j * SGU_G * SGU_T * SGU_T; const float* b_s = F.a_b_s + (size_t)j * SGU_G * SGU_T; const float* g_v = F.a_g_v + (size_t)j * DI;
    const int tid = F.tid, lane = F.lane, w = F.wave, fr = lane & 15, fq = lane >> 4;
    LAS float* rinv = (LAS float*)(F.lds + MX_RINV);
    const unsigned trbase = lds_u32(F.lds + MX_GV) + (unsigned)((8 * fq + (fr >> 2)) * MX_GSTR + (32 * w + 8 * (lane & 3)) * 2);
    for (int u = blockIdx.x; u < 128 * SGU_G; u += F.G) {
        const int c = u >> 3, g = u & 7, r0 = c * 128;
        const int row = tid >> 5, ch = tid & 31;
        v4u gvr[8]; f32x4 wr[8];
#pragma unroll
        for (int i = 0; i < 8; ++i) gvr[i] = *(const v4u*)(GV + (size_t)(r0 + row + 16 * i) * DI + g * 256 + ch * 8);
#pragma unroll
        for (int i = 0; i < 8; ++i) wr[i] = *(const f32x4*)(w_s + ((size_t)g * 128 + row + 16 * i) * 128 + ch * 4);
        if (tid < 128) { const f32x4* p = (const f32x4*)(ssq + (size_t)(r0 + tid) * 32); float s = 0.f;
#pragma unroll
            for (int i = 0; i < 8; ++i) { const f32x4 v = p[i]; s += (v.x + v.y) + (v.z + v.w); }
            rinv[tid] = 1.0f / sqrtf(s * (1.f / DI) + EPS); }
        __syncthreads();
        { const f32x4 ri = *(const LAS f32x4*)(rinv + ch * 4); const int s0 = ch * 4;
#pragma unroll
          for (int i = 0; i < 8; ++i) { const int t = row + 16 * i; f32x4 v = wr[i] * ri;
              v.x = (s0 <= t) ? v.x : 0.f; v.y = (s0 + 1 <= t) ? v.y : 0.f; v.z = (s0 + 2 <= t) ? v.z : 0.f; v.w = (s0 + 3 <= t) ? v.w : 0.f;
              v2u o; o.x = pk2(v.x, v.y); o.y = pk2(v.z, v.w);
              *(LAS v2u*)(F.lds + MX_WM + t * MX_WSTR + s0 * 2) = o;
              *(LAS v4u*)(F.lds + MX_GV + t * MX_GSTR + ch * 16) = gvr[i]; } }
        __syncthreads();
        const int dcol = g * 256 + 32 * w + 8 * fq;
        v4u uz[8];
#pragma unroll
        for (int tt = 0; tt < 8; ++tt) uz[tt] = *(const v4u*)(UZ + (size_t)(r0 + 16 * tt + fr) * DI + dcol);
        f32x4 acc[2][8];
#pragma unroll
        for (int a = 0; a < 2; ++a)
#pragma unroll
            for (int tt = 0; tt < 8; ++tt) acc[a][tt] = (f32x4){0.f, 0.f, 0.f, 0.f};
        mix_kstep<0>(F.lds, trbase, fr, fq, acc); mix_kstep<1>(F.lds, trbase, fr, fq, acc); mix_kstep<2>(F.lds, trbase, fr, fq, acc); mix_kstep<3>(F.lds, trbase, fr, fq, acc);
        const f32x4 g0 = *(const f32x4*)(g_v + dcol), g1 = *(const f32x4*)(g_v + dcol + 4);
#pragma unroll
        for (int tt = 0; tt < 8; ++tt) {
            const float bs = b_s[g * 128 + 16 * tt + fr];
            const f32x4 y0 = (acc[0][tt] * g0 + bs) * unpk_lo((v2u){uz[tt].x, uz[tt].y}), y1 = (acc[1][tt] * g1 + bs) * unpk_lo((v2u){uz[tt].z, uz[tt].w});
            v4u o; o.x = pk2(y0.x, y0.y); o.y = pk2(y0.z, y0.w); o.z = pk2(y1.x, y1.y); o.w = pk2(y1.z, y1.w);
            *(v4u*)(UZ + (size_t)(r0 + 16 * tt + fr) * DI + dcol) = o;
        }
    }
    __syncthreads();
}

__device__ __forceinline__ void gla_prep_phase(Frame& F, int j) {
    bf16* Q = (bf16*)(F.ws + WS_Q); bf16* Kk = (bf16*)(F.ws + WS_K); const float* ALR = (const float*)(F.ws + WS_ALR); float* DEC = (float*)(F.ws + WS_DEC);
    const float* wg = F.b_w_gate_up + (size_t)j * GRANK * 512; const float* bg = F.b_b_gate + (size_t)j * 512;
    LAS float* alr = (LAS float*)F.lds;
    LAS float* tot = (LAS float*)(F.lds + 4096);
    const int tid = F.tid, kp = tid & 63, ts = F.wave;
    for (int u = blockIdx.x; u < BATCH * GNC * GH; u += F.G) {
        const int h = u & 3, c = (u >> 2) & 31, b = u >> 7, r0 = b * SEQ + c * GL, col = h * GDK + 2 * kp;
        if (tid < 256) *(LAS f32x4*)(alr + tid * 4) = *(const f32x4*)(ALR + (size_t)r0 * GRANK + tid * 4);
        unsigned qv[8], kv[8];
#pragma unroll
        for (int tt = 0; tt < 8; ++tt) { const size_t o = (size_t)(r0 + ts * 8 + tt) * 512 + col; qv[tt] = *(const unsigned*)(Q + o); kv[tt] = *(const unsigned*)(Kk + o); }
        f32x2 wv[16];
#pragma unroll
        for (int i = 0; i < 16; ++i) wv[i] = *(const f32x2*)(wg + i * 512 + col);
        const f32x2 bgv = *(const f32x2*)(bg + col);
        __syncthreads();
        f32x2 cs[8]; f32x2 run = {0.f, 0.f};
#pragma unroll
        for (int tt = 0; tt < 8; ++tt) {
            const LAS f32x4* ar = (const LAS f32x4*)(alr + (ts * 8 + tt) * 16);
            f32x2 g = bgv;
#pragma unroll
            for (int q4 = 0; q4 < 4; ++q4) { const f32x4 a = ar[q4]; g += wv[4 * q4] * a.x + wv[4 * q4 + 1] * a.y + wv[4 * q4 + 2] * a.z + wv[4 * q4 + 3] * a.w; }
            f32x2 la;
            la.x = (fminf(g.x, 0.f) - __logf(1.0f + __expf(-fabsf(g.x)))) * (1.f / 16.f);
            la.y = (fminf(g.y, 0.f) - __logf(1.0f + __expf(-fabsf(g.y)))) * (1.f / 16.f);
            run += la; cs[tt] = run;
        }
        *(LAS f32x2*)(tot + ts * 128 + 2 * kp) = run;
        __syncthreads();
        f32x2 pre = {0.f, 0.f}, all = {0.f, 0.f};
#pragma unroll
        for (int s = 0; s < 8; ++s) { const f32x2 t2 = *(const LAS f32x2*)(tot + s * 128 + 2 * kp); all += t2; if (s < ts) pre += t2; }
#pragma unroll
        for (int tt = 0; tt < 8; ++tt) {
            const f32x2 bb = pre + cs[tt];
            const float e0 = __expf(bb.x), e1 = __expf(bb.y), i0 = __expf(-bb.x), i1 = __expf(-bb.y);
            const size_t o = (size_t)(r0 + ts * 8 + tt) * 512 + col;
            *(unsigned*)(Q + o) = pk2(bflo(qv[tt]) * e0, bfhi(qv[tt]) * e1);
            *(unsigned*)(Kk + o) = pk2(bflo(kv[tt]) * i0, bfhi(kv[tt]) * i1);
        }
        if (ts == 0) { f32x2 d; d.x = __expf(all.x); d.y = __expf(all.y); *(f32x2*)(DEC + (((size_t)b * GNC + c) * GH + h) * GDK + 2 * kp) = d; }
        __syncthreads();
    }
}

constexpr int SC_QSTR = 272, SC_VSTR = 144;
constexpr int SC_QD = 0, SC_KI = 64 * SC_QSTR, SC_V = 2 * 64 * SC_QSTR, SC_DEC = SC_V + 64 * SC_VSTR, SC_ATT = SC_DEC + 512, SC_OX = SC_ATT + 64 * SC_VSTR, SC_SSQ = SC_OX + 16384, SC_END = SC_SSQ + 1024;
static_assert(SC_END <= RING_BYTES && SC_OX % 16 == 0 && SC_ATT % 16 == 0 && SC_V % 16 == 0, "scan LDS");
__device__ __forceinline__ void gla_scan_phase(Frame& F, int j) {
    const bf16* QD = (const bf16*)(F.ws + WS_Q); const bf16* KI = (const bf16*)(F.ws + WS_K); const bf16* V = (const bf16*)(F.ws + WS_V); bf16* SZ = (bf16*)(F.ws + WS_SZ);
    const float* DEC = (const float*)(F.ws + WS_DEC); float* SSQB = (float*)(F.ws + WS_SSQB); const float* g_o = F.b_g_o + (size_t)j * GDV;
    const int tid = F.tid, lane = F.lane, w = F.wave, fr = lane & 15, fq = lane >> 4, vt = w & 3, hf = w >> 2;
    const int bid = blockIdx.x, bh = (bid & 7) * 4 + (bid >> 6), vs = (bid >> 3) & 7, b = bh >> 2, h = bh & 3;
    const LAS unsigned char* L = F.lds;
    const int qrow = tid >> 4, qch = tid & 15, vrow = tid >> 3, vch = tid & 7;
    const bf16* qg = QD + (size_t)(b * SEQ + qrow) * 512 + h * GDK + qch * 8;
    const bf16* kg = KI + (size_t)(b * SEQ + qrow) * 512 + h * GDK + qch * 8;
    const bf16* vg = V + (size_t)(b * SEQ + vrow) * DI + h * GDV + vs * 64 + vch * 8;
    const float* dg = DEC + ((size_t)b * GNC * GH + h) * GDK + (tid & 31) * 4;
    v4u sq0, sq1, sk0, sk1, sv; f32x4 sd = {0.f, 0.f, 0.f, 0.f};
#define SC_LOAD(c) do { const size_t ro = (size_t)(c) * GL; sq0 = *(const v4u*)(qg + ro * 512); sq1 = *(const v4u*)(qg + (ro + 32) * 512); sk0 = *(const v4u*)(kg + ro * 512); sk1 = *(const v4u*)(kg + (ro + 32) * 512); \
        sv = *(const v4u*)(vg + ro * DI); if (tid < 32) sd = *(const f32x4*)(dg + (size_t)(c) * GH * GDK); } while (0)
#define SC_STORE() do { *(LAS v4u*)(F.lds + SC_QD + qrow * SC_QSTR + qch * 16) = sq0; *(LAS v4u*)(F.lds + SC_QD + (qrow + 32) * SC_QSTR + qch * 16) = sq1; \
        *(LAS v4u*)(F.lds + SC_KI + qrow * SC_QSTR + qch * 16) = sk0; *(LAS v4u*)(F.lds + SC_KI + (qrow + 32) * SC_QSTR + qch * 16) = sk1; \
        *(LAS v4u*)(F.lds + SC_V + vrow * SC_VSTR + vch * 16) = sv; if (tid < 32) *(LAS f32x4*)(F.lds + SC_DEC + tid * 16) = sd; } while (0)
    f32x4 S[4];
#pragma unroll
    for (int i = 0; i < 4; ++i) S[i] = (f32x4){0.f, 0.f, 0.f, 0.f};
    SC_LOAD(0); SC_STORE();
    __syncthreads();
    const unsigned kibase = lds_u32(F.lds + SC_KI) + (unsigned)((8 * fq + (fr >> 2)) * SC_QSTR + (64 * hf + 4 * (lane & 3)) * 2);
    const unsigned vbase = lds_u32(F.lds + SC_V) + (unsigned)((8 * fq + (fr >> 2)) * SC_VSTR + (16 * vt + 4 * (lane & 3)) * 2);
    const int r00 = b * SEQ;
    const size_t ocol = (size_t)h * GDV + vs * 64 + 16 * vt + 4 * fq;
    const f32x4 gov = *(const f32x4*)(g_o + vs * 64 + 16 * vt + 4 * fq);
    for (int c = 0; c < GNC; ++c) {
        const int r0 = r00 + c * GL;
        if (c > 0 && tid < 64) { const LAS float* sp = (const LAS float*)(L + SC_SSQ); SSQB[(size_t)(r0 - GL + tid) * 32 + h * 8 + vs] = (sp[tid] + sp[64 + tid]) + (sp[128 + tid] + sp[192 + tid]); }
        if (c + 1 < GNC) SC_LOAD(c + 1);
        v2u szr[2];
#pragma unroll
        for (int i = 0; i < 2; ++i) szr[i] = *(const v2u*)(SZ + (size_t)(r0 + 16 * (2 * hf + i) + fr) * DI + ocol);
        {
            const int tta = w >> 1;
#pragma unroll
            for (int si = 0; si < 2; ++si) {
                const int st = 2 * (w & 1) + si;
                f32x4 a = {0.f, 0.f, 0.f, 0.f};
                if (st <= tta) {
#pragma unroll
                    for (int ks = 0; ks < 4; ++ks) {
                        const bf16x8 A = *(const LAS bf16x8*)(L + SC_KI + (16 * st + fr) * SC_QSTR + 64 * ks + 16 * fq);
                        const bf16x8 B = *(const LAS bf16x8*)(L + SC_QD + (16 * tta + fr) * SC_QSTR + 64 * ks + 16 * fq);
                        a = __builtin_amdgcn_mfma_f32_16x16x32_bf16(A, B, a, 0, 0, 0);
                    }
                }
                const int t = 16 * tta + fr, s0 = 16 * st + 4 * fq;
                a.x = (s0 <= t) ? a.x : 0.f; a.y = (s0 + 1 <= t) ? a.y : 0.f; a.z = (s0 + 2 <= t) ? a.z : 0.f; a.w = (s0 + 3 <= t) ? a.w : 0.f;
                v2u o; o.x = pk2(a.x, a.y); o.y = pk2(a.z, a.w);
                *(LAS v2u*)(F.lds + SC_ATT + t * SC_VSTR + s0 * 2) = o;
            }
        }
        f32x4 oT[4];
#pragma unroll
        for (int tt = 0; tt < 4; ++tt) oT[tt] = (f32x4){0.f, 0.f, 0.f, 0.f};
#pragma unroll
        for (int kb = 0; kb < 2; ++kb) {
            v4u aw; aw.x = pk2(S[2 * kb].x, S[2 * kb].y); aw.y = pk2(S[2 * kb].z, S[2 * kb].w); aw.z = pk2(S[2 * kb + 1].x, S[2 * kb + 1].y); aw.w = pk2(S[2 * kb + 1].z, S[2 * kb + 1].w);
            const bf16x8 A = __builtin_bit_cast(bf16x8, aw);
#pragma unroll
            for (int tt = 0; tt < 4; ++tt) {
                const LAS unsigned char* qp = L + SC_QD + (16 * tt + fr) * SC_QSTR + (64 * hf + 32 * kb + 4 * fq) * 2;
                const s16x4 b0 = *(const LAS s16x4*)qp, b1 = *(const LAS s16x4*)(qp + 32);
                oT[tt] = __builtin_amdgcn_mfma_f32_16x16x32_bf16(A, cat4(b0, b1), oT[tt], 0, 0, 0);
            }
        }
        bf16x8 Vf[2];
        {
            s16x4 v00, v01, v10, v11;
            tr4<0, 4 * SC_VSTR, 32 * SC_VSTR, 36 * SC_VSTR>(vbase, v00, v01, v10, v11);
            __builtin_amdgcn_sched_barrier(0);
            Vf[0] = cat4(v00, v01); Vf[1] = cat4(v10, v11);
            s16x4 k0, k1, k2, k3;
#define SC_KSTEP(i) do { tr4<(i) * 32, (i) * 32 + 4 * SC_QSTR, (i) * 32 + 32 * SC_QSTR, (i) * 32 + 36 * SC_QSTR>(kibase, k0, k1, k2, k3); __builtin_amdgcn_sched_barrier(0); \
            S[i] = __builtin_amdgcn_mfma_f32_16x16x32_bf16(cat4(k0, k1), Vf[0], S[i], 0, 0, 0); S[i] = __builtin_amdgcn_mfma_f32_16x16x32_bf16(cat4(k2, k3), Vf[1], S[i], 0, 0, 0); \
            S[i] = S[i] * *(const LAS f32x4*)(L + SC_DEC + (64 * hf + 16 * (i) + 4 * fq) * 4); } while (0)
            SC_KSTEP(0); SC_KSTEP(1); SC_KSTEP(2); SC_KSTEP(3);
#undef SC_KSTEP
        }
        __syncthreads();
#pragma unroll
        for (int tt = 0; tt < 4; ++tt) {
            if (tt >= 2 * hf) {
                const bf16x8 B = *(const LAS bf16x8*)(L + SC_ATT + (16 * tt + fr) * SC_VSTR + 64 * hf + 16 * fq);
                oT[tt] = __builtin_amdgcn_mfma_f32_16x16x32_bf16(Vf[hf], B, oT[tt], 0, 0, 0);
            }
        }
        {
            LAS f32x4* ox = (LAS f32x4*)(F.lds + SC_OX) + w * 128 + lane;
            if (hf == 0) { ox[0] = oT[2]; ox[64] = oT[3]; } else { ox[0] = oT[0]; ox[64] = oT[1]; }
        }
        __syncthreads();
        {
            const LAS f32x4* px = (const LAS f32x4*)(L + SC_OX) + (w ^ 4) * 128 + lane;
            f32x4 o0 = (hf == 0 ? oT[0] : oT[2]) + px[0], o1 = (hf == 0 ? oT[1] : oT[3]) + px[64];
            float s0 = (o0.x * o0.x + o0.y * o0.y) + (o0.z * o0.z + o0.w * o0.w), s1 = (o1.x * o1.x + o1.y * o1.y) + (o1.z * o1.z + o1.w * o1.w);
            s0 += __shfl_xor(s0, 16); s0 += __shfl_xor(s0, 32); s1 += __shfl_xor(s1, 16); s1 += __shfl_xor(s1, 32);
            if (fq == 0) { LAS float* sp = (LAS float*)(F.lds + SC_SSQ) + vt * 64; sp[16 * (2 * hf) + fr] = s0; sp[16 * (2 * hf + 1) + fr] = s1; }
            const f32x4 y0 = o0 * gov * unpk_lo(szr[0]), y1 = o1 * gov * unpk_lo(szr[1]);
            v2u w0, w1; w0.x = pk2(y0.x, y0.y); w0.y = pk2(y0.z, y0.w); w1.x = pk2(y1.x, y1.y); w1.y = pk2(y1.z, y1.w);
            *(v2u*)(SZ + (size_t)(r0 + 16 * (2 * hf) + fr) * DI + ocol) = w0;
            *(v2u*)(SZ + (size_t)(r0 + 16 * (2 * hf + 1) + fr) * DI + ocol) = w1;
        }
        if (c + 1 < GNC) SC_STORE();
        __syncthreads();
    }
    if (tid < 64) { const LAS float* sp = (const LAS float*)(L + SC_SSQ); SSQB[(size_t)(r00 + (GNC - 1) * GL + tid) * 32 + h * 8 + vs] = (sp[tid] + sp[64 + tid]) + (sp[128 + tid] + sp[192 + tid]); }
    __syncthreads();
#undef SC_LOAD
#undef SC_STORE
}

__device__ __forceinline__ void gla_norm_phase(Frame& F) {
    bf16* A = (bf16*)(F.ws + WS_SZ); const float* SSQB = (const float*)(F.ws + WS_SSQB);
    const int gw = F.vcu * NWAVES + F.wave, rows_per = M / (F.G * NWAVES), r0 = gw * rows_per;
    for (int r = r0; r < r0 + rows_per; ++r) {
        const f32x4* sp = (const f32x4*)(SSQB + (size_t)r * 32);
        float ri[4];
#pragma unroll
        for (int hh = 0; hh < 4; ++hh) { const f32x4 a = sp[2 * hh], bq = sp[2 * hh + 1]; ri[hh] = 1.0f / sqrtf(((a.x + a.y) + (a.z + a.w) + (bq.x + bq.y) + (bq.z + bq.w)) * (1.f / GDV) + EPS); }
        GAS v4u* ap = (GAS v4u*)(A + (size_t)r * DI) + F.lane;
#pragma unroll
        for (int i = 0; i < 4; ++i) { v4u v = ap[64 * i]; const float s = ri[i];
            v.x = pk2(bflo(v.x) * s, bfhi(v.x) * s); v.y = pk2(bflo(v.y) * s, bfhi(v.y) * s); v.z = pk2(bflo(v.z) * s, bfhi(v.z) * s); v.w = pk2(bflo(v.w) * s, bfhi(v.w) * s);
            ap[64 * i] = v; }
    }
}

struct Args { const float* in[16]; float* out; unsigned char* ws; int ph_lo, ph_hi, li, pad; };
constexpr int NPH = 2 + 6 * DEPTH;
__host__ __device__ constexpr bool phase_exists(int ph) {
    if (ph < 2) return true;
    const int l = (ph - 2) / 6, k = (ph - 2) % 6;
    if ((l & 1) == 0 && (k == 2 || k == 3)) return false;
    return true;
}

__global__ void __launch_bounds__(NTHREADS, 2) fwd(Args args) {
    extern __shared__ __attribute__((aligned(16))) unsigned char lds[];
    Frame F;
    F.lds = (LAS unsigned char*)lds;
    F.tid = threadIdx.x; F.lane = F.tid & 63; F.wave = __builtin_amdgcn_readfirstlane(F.tid >> 6);
    F.G = gridDim.x; { const int bx = blockIdx.x; F.vcu = (F.G % 8 == 0) ? (bx % 8) * (F.G / 8) + bx / 8 : bx; }
    F.x = args.in[0]; F.c = args.in[1]; F.w_ada = args.in[2]; F.b_ada = args.in[3]; F.g_norm = args.in[4]; F.a_w_in = args.in[5]; F.a_w_s = args.in[6]; F.a_b_s = args.in[7];
    F.a_g_v = args.in[8]; F.a_w_out = args.in[9]; F.b_w_in = args.in[10]; F.b_w_gate_up = args.in[11]; F.b_b_gate = args.in[12]; F.b_g_o = args.in[13]; F.b_w_out = args.in[14]; F.g_final = args.in[15];
    F.out = args.out; F.ws = args.ws;
    volatile LAS unsigned* MISC = (volatile LAS unsigned*)(F.lds + MISC_OFF);
    for (int u = F.tid; u < (LDS_BYTES - LDSCTL_OFF) / 4; u += NTHREADS) ((LAS unsigned*)(F.lds + LDSCTL_OFF))[u] = 0u;
    __syncthreads();
    XcdBarrier bar; bar.bar = (unsigned*)(F.ws + WS_CTL) + CW_BAR; bar.x = 0; bar.st = nullptr;
    const bool multi = (args.ph_hi - args.ph_lo) > 1;
    if (multi) bar = xcd_barrier_post((unsigned*)(F.ws + WS_CTL) + CW_BAR, MISC + 8);

    for (int ph = args.ph_lo; ph < args.ph_hi; ++ph) {
        if (!phase_exists(ph)) continue;
        {
            int t_ = threadIdx.x; asm volatile("" : "+v"(t_)); F.tid = t_; F.lane = t_ & 63; F.wave = __builtin_amdgcn_readfirstlane(t_ >> 6);
            int bx = blockIdx.x; asm volatile("" : "+s"(bx)); F.vcu = (bx % 8) * (F.G / 8) + bx / 8;
            unsigned char* w_ = args.ws; asm volatile("" : "+s"(w_)); F.ws = w_;
        }
        if (ph == 0) p0_prologue(F);
        else if (ph == 1) h_pass(F, F.x, 0);
        else {
            const int l = (ph - 2) / 6, k = (ph - 2) % 6, j = l >> 1; const bool isA = (l & 1) == 0;
            const float* modl = (const float*)(F.ws + WS_MOD) + (size_t)l * BATCH * 3 * D;
            if (k == 0) {
                if (isA) {
                    pg8::Gemm g{(const bf16*)(F.ws + WS_H), (const bf16*)(F.ws + WS_WAIN) + (size_t)j * A_IN * D, M, A_IN, D}; pg8::StaticOrder S; S.init(M, A_IN, F.G, (int)blockIdx.x);
                    pg8::EpiA1 E{(bf16*)(F.ws + WS_UZ), (bf16*)(F.ws + WS_GV), (float*)(F.ws + WS_SSQA)};
                    pg8::gemm_phase<pg8::EpiA1, pg8::StaticOrder, true, true>(F.lds, g, S, E);
                } else {
                    pg8::Gemm g{(const bf16*)(F.ws + WS_H), (const bf16*)(F.ws + WS_WBIN) + (size_t)j * B_INW * D, M, B_N, D}; pg8::StaticOrder S; S.init(M, B_N, F.G, (int)blockIdx.x);
                    pg8::EpiB1 E{(bf16*)(F.ws + WS_Q), (bf16*)(F.ws + WS_K), (bf16*)(F.ws + WS_V), (bf16*)(F.ws + WS_SZ)};
                    pg8::gemm_phase<pg8::EpiB1, pg8::StaticOrder, true, true>(F.lds, g, S, E);
                    alr_phase(F, j);
                }
            } else if (k == 1) {
                if (isA) mix_phase(F, j); else gla_prep_phase(F, j);
            } else if (k == 2) { gla_scan_phase(F, j);
            } else if (k == 3) { gla_norm_phase(F);
            } else if (k == 4) {
                const bf16* A = isA ? (const bf16*)(F.ws + WS_UZ) : (const bf16*)(F.ws + WS_SZ);
                const bf16* Bt = isA ? (const bf16*)(F.ws + WS_WAOUT) + (size_t)j * D * DI : (const bf16*)(F.ws + WS_WBOUT) + (size_t)j * D * DI;
                pg8::Gemm g{A, Bt, M, D, DI}; pg8::StaticOrder S; S.init(M, D, F.G, (int)blockIdx.x);
                pg8::EpiOut E{l == 0 ? F.x : F.out, F.out, modl + 2 * D};
                pg8::gemm_phase<pg8::EpiOut, pg8::StaticOrder, false, true>(F.lds, g, S, E);
            } else {
                if (l + 1 < DEPTH) h_pass(F, F.out, l + 1); else final_norm(F, F.out);
            }
        }
        if (multi && ph + 1 < args.ph_hi) xcd_barrier(bar);
    }
}

extern "C" void kernel_launch(void* const* d_in, const int* in_sizes, int n_in, void* d_out, int out_size, void* d_ws, size_t ws_size, hipStream_t stream) {
    static int grid = 0;
    if (grid == 0) {
        if (n_in != 16 || in_sizes[0] != M * D || out_size != M * D || ws_size < WS_END) { fprintf(stderr, "kernel_launch: unexpected shapes (n_in %d, in0 %d, out %d, ws %zu); nothing launched\n", n_in, n_in > 0 ? in_sizes[0] : -1, out_size, ws_size); grid = -1; return; }
        int dev = 0, cus = 0;
        if (hipGetDevice(&dev) != hipSuccess || hipDeviceGetAttribute(&cus, hipDeviceAttributeMultiprocessorCount, dev) != hipSuccess) { grid = -1; return; }
        if (hipFuncSetAttribute((const void*)fwd, hipFuncAttributeMaxDynamicSharedMemorySize, LDS_BYTES) != hipSuccess) { fprintf(stderr, "kernel_launch: hipFuncSetAttribute failed\n"); grid = -1; return; }
        (void)hipGetLastError();
        grid = cus;
        if (grid != 256) { fprintf(stderr, "kernel_launch: built for 256 CUs, device has %d; nothing launched\n", cus); grid = -1; return; }
    }
    if (grid < 0) return;
    (void)hipMemsetAsync((char*)d_ws + WS_CTL, 0, CTL_ZERO_BYTES, stream);
    Args a{};
    for (int i = 0; i < 16; ++i) a.in[i] = (const float*)d_in[i];
    a.out = (float*)d_out; a.ws = (unsigned char*)d_ws;
#if MK_PER_PHASE
    unsigned char* ws = (unsigned char*)d_ws;
    for (int ph = 0; ph < NPH; ++ph) {
        if (!phase_exists(ph)) continue;
        const int l = ph >= 2 ? (ph - 2) / 6 : -1, k = ph >= 2 ? (ph - 2) % 6 : -1, j = l >> 1; const bool isA = (l & 1) == 0;
        (void)j; (void)isA; (void)k;
#if NAIVE_MIX
        if (l >= 0 && isA && k == 1) {
            naive_mix<<<1024, 256, 0, stream>>>((const bf16*)(ws + WS_GV), (bf16*)(ws + WS_UZ), (const float*)(ws + WS_SSQA), a.in[6] + (size_t)j * SGU_G * SGU_T * SGU_T, a.in[7] + (size_t)j * SGU_G * SGU_T, a.in[8] + (size_t)j * DI);
            continue;
        }
#endif
#if NAIVE_GLA
        if (l >= 0 && !isA && k == 1) { naive_la<<<M * 512 / 256, 256, 0, stream>>>((const float*)(ws + WS_ALR), a.in[11] + (size_t)j * GRANK * 512, a.in[12] + (size_t)j * 512, (float*)(ws + WS_LA)); continue; }
        if (l >= 0 && !isA && k == 2) { naive_scan<<<256, 256, 0, stream>>>((const bf16*)(ws + WS_Q), (const bf16*)(ws + WS_K), (bf16*)(ws + WS_V), (const float*)(ws + WS_LA)); continue; }
        if (l >= 0 && !isA && k == 3) { naive_gla_norm<<<M, 256, 0, stream>>>((const bf16*)(ws + WS_V), (bf16*)(ws + WS_SZ), a.in[13] + (size_t)j * GDV); continue; }
#endif
        a.ph_lo = ph; a.ph_hi = ph + 1; a.li = 0;
        hipLaunchKernelGGL(fwd, dim3(grid), dim3(NTHREADS), LDS_BYTES, stream, a);
    }
#else
    a.ph_lo = 0; a.ph_hi = NPH; a.li = 0;
    hipLaunchKernelGGL(fwd, dim3(grid), dim3(NTHREADS), LDS_BYTES, stream, a);
#endif
    const hipError_t le = hipPeekAtLastError();
    if (le != hipSuccess) fprintf(stderr, "kernel_launch: launch failed: %s\n", hipGetErrorName(le));
}
```

```cpp
#include <hip/hip_runtime.h>
#include <cstdio>
#include <cstdint>

#ifndef MK_PER_PHASE
#define MK_PER_PHASE 0
#endif
#ifndef NAIVE_MIX
#define NAIVE_MIX 0
#endif
#ifndef NAIVE_GLA
#define NAIVE_GLA 0
#endif

constexpr int D = 1024, BATCH = 8, SEQ = 2048, M = BATCH * SEQ, DI = 2048, DEPTH = 4;
constexpr int A_IN = 3 * DI;
constexpr int B_N = 5120, B_INW = 5136;
constexpr int SGU_T = 128, SGU_G = 8, SGU_GD = 256;
constexpr int GH = 4, GDK = 128, GDV = 512, GL = 64, GNC = SEQ / GL, GRANK = 16;
constexpr float EPS = 1e-6f;

#define GAS __attribute__((address_space(1)))
#define LAS __attribute__((address_space(3)))
typedef unsigned short bf16;
typedef unsigned v4u __attribute__((ext_vector_type(4)));
typedef unsigned v2u __attribute__((ext_vector_type(2)));
typedef float f32x4 __attribute__((ext_vector_type(4)));
typedef float f32x2 __attribute__((ext_vector_type(2)));
typedef short bf16x8 __attribute__((ext_vector_type(8)));
typedef short bf16x4 __attribute__((ext_vector_type(4)));

__device__ __forceinline__ unsigned f2bf(float f) { unsigned u = __builtin_bit_cast(unsigned, f); return (u + 0x7fffu + ((u >> 16) & 1u)) >> 16; }
__device__ __forceinline__ unsigned pk2(float lo, float hi) { return f2bf(lo) | (f2bf(hi) << 16); }
__device__ __forceinline__ float bf2f(unsigned b) { return __builtin_bit_cast(float, b << 16); }
__device__ __forceinline__ float bflo(unsigned w) { return __builtin_bit_cast(float, w << 16); }
__device__ __forceinline__ float bfhi(unsigned w) { return __builtin_bit_cast(float, w & 0xffff0000u); }
__device__ __forceinline__ float fast_sigmoid(float x) { return __builtin_amdgcn_rcpf(1.0f + __builtin_amdgcn_exp2f(-1.44269504089f * x)); }
__device__ __forceinline__ float silu_f(float x) { return x * fast_sigmoid(x); }
__device__ __forceinline__ float gelu_f(float x) { const float y = 1.5957691216057308f * x * (1.0f + 0.044715f * x * x); return x * fast_sigmoid(y); }
__device__ __forceinline__ float wave_sum(float v) {
#pragma unroll
    for (int o = 1; o < 64; o <<= 1) v += __shfl_xor(v, o);
    return v;
}

namespace pg8 {
#define PG8_LAS __attribute__((address_space(3)))
typedef unsigned short bf16_t;
typedef short bf16x8 __attribute__((ext_vector_type(8)));
typedef float f32x4 __attribute__((ext_vector_type(4)));
typedef unsigned u32x4 __attribute__((ext_vector_type(4)));
constexpr int BM = 256, BK = 64, HALF = 128, HTB = HALF * BK * 2  , STAGE_BYTES = 8 * HTB, NXCD = 8, WGM = 8;

__host__ __device__ __forceinline__ int lds_byte(int r, int c) { const int st = (r >> 4) * 2 + (c >> 5), rr = r & 15, cc = c & 31, ob = rr * 64 + cc * 2; return st * 1024 + (ob ^ (((ob >> 9) & 1) << 5)); }
__host__ __device__ __forceinline__ void stage_rc(int b, int& R, int& C) { const int st = b / 1024, sb = b % 1024, swz = sb ^ (((sb >> 9) & 1) << 5); R = (st >> 1) * 16 + swz / 64; C = (st & 1) * 32 + (swz % 64) / 2; }
__host__ __device__ __forceinline__ int perm32(int rho) { const int n = rho >> 4, i = rho & 15; return 8 * (i >> 2) + 4 * n + (i & 3); }

struct Unit { int pm, pn; };
struct Gemm { const GAS bf16_t* A; const GAS bf16_t* Bt; int M, N, K; };

struct StaticOrder {
    int nM, nN, nwg, G, c;
    __host__ __device__ void init(int M, int N, int G_, int c_) { nM = M / BM; nN = N / BM; nwg = nM * nN; G = G_; c = c_; }
    __host__ __device__ bool next(int i, Unit& u) const {
        const long L = (long)i * G + c; if (L >= nwg) return false;
        int wgid = (int)L; { const int q = nwg / NXCD, r = nwg % NXCD, xcd = wgid % NXCD, off = wgid / NXCD; wgid = (xcd < r ? xcd * (q + 1) : r * (q + 1) + (xcd - r) * q) + off; }
        const int nig = WGM * nN, gid = wgid / nig, fm = gid * WGM, gsz = (nM - fm) < WGM ? (nM - fm) : WGM;
        u.pm = fm + ((wgid % nig) % gsz); u.pn = (wgid % nig) / gsz; return true;
    }
    __device__ __forceinline__ void a_ready(const Unit&) const {}
    __device__ __forceinline__ void done(const Unit&) const {}
};

__device__ __forceinline__ u32x4 pack8(const f32x4 a, const f32x4 b) { u32x4 w; w.x = pk2(a[0], a[1]); w.y = pk2(a[2], a[3]); w.z = pk2(b[0], b[1]); w.w = pk2(b[2], b[3]); return w; }

struct EpiA1 {
    static constexpr bool PERM = true, AFTER_DRAIN = false;
    GAS bf16_t* UZ; GAS bf16_t* GV; GAS float* ssq;
    __device__ __forceinline__ void operator()(const f32x4 (&acc)[2][2][4][2], const Unit& u, int wr, int wc, int fr, int fq) const {
        const int row0 = u.pm * BM + wr * 64 + fr;
        if (u.pn < 16) {
            const int ch0 = u.pn * 128 + wc * 32 + 8 * fq;
#pragma unroll
            for (int ai = 0; ai < 2; ++ai)
#pragma unroll
                for (int m = 0; m < 4; ++m) {
                    f32x4 r0, r1;
#pragma unroll
                    for (int i = 0; i < 4; ++i) { r0[i] = gelu_f(acc[ai][0][m][0][i]) * silu_f(acc[ai][1][m][0][i]); r1[i] = gelu_f(acc[ai][0][m][1][i]) * silu_f(acc[ai][1][m][1][i]); }
                    *(GAS u32x4*)(UZ + (size_t)(row0 + ai * HALF + m * 16) * DI + ch0) = pack8(r0, r1);
                }
        } else {
            const int j = u.pn - 16, col0 = j * 256 + wc * 32 + 8 * fq;
#pragma unroll
            for (int ai = 0; ai < 2; ++ai)
#pragma unroll
                for (int m = 0; m < 4; ++m) {
                    const int row = row0 + ai * HALF + m * 16; float s = 0.f;
#pragma unroll
                    for (int bj = 0; bj < 2; ++bj) {
                        f32x4 r0, r1;
#pragma unroll
                        for (int i = 0; i < 4; ++i) { r0[i] = gelu_f(acc[ai][bj][m][0][i]); r1[i] = gelu_f(acc[ai][bj][m][1][i]); s += r0[i] * r0[i] + r1[i] * r1[i]; }
                        *(GAS u32x4*)(GV + (size_t)row * DI + col0 + bj * HALF) = pack8(r0, r1);
                    }
                    s += __shfl_xor(s, 16); s += __shfl_xor(s, 32);
                    if (fq == 0) ssq[(size_t)row * 32 + j * 4 + wc] = s;
                }
        }
    }
};

struct EpiB1 {
    static constexpr bool PERM = true, AFTER_DRAIN = false;
    GAS bf16_t* Q; GAS bf16_t* Kk; GAS bf16_t* V; GAS bf16_t* SZ;
    __device__ __forceinline__ void operator()(const f32x4 (&acc)[2][2][4][2], const Unit& u, int wr, int wc, int fr, int fq) const {
        const int row0 = u.pm * BM + wr * 64 + fr, lc = wc * 32 + 8 * fq;
        GAS bf16_t* base; int ld; int mode = 0;
        if (u.pn < 2) { base = Q + u.pn * 256; ld = 512; mode = 1; }
        else if (u.pn < 4) { base = Kk + (u.pn - 2) * 256; ld = 512; }
        else if (u.pn < 12) { base = V + (u.pn - 4) * 256; ld = DI; }
        else { base = SZ + (u.pn - 12) * 256; ld = DI; mode = 2; }
#pragma unroll
        for (int ai = 0; ai < 2; ++ai)
#pragma unroll
            for (int m = 0; m < 4; ++m) {
                GAS bf16_t* rowp = base + (size_t)(row0 + ai * HALF + m * 16) * ld + lc;
#pragma unroll
                for (int bj = 0; bj < 2; ++bj) {
                    f32x4 r0 = acc[ai][bj][m][0], r1 = acc[ai][bj][m][1];
                    if (mode == 1) { r0 = r0 * 0.08838834764831845f; r1 = r1 * 0.08838834764831845f; }
                    else if (mode == 2) {
#pragma unroll
                        for (int i = 0; i < 4; ++i) { r0[i] = silu_f(r0[i]); r1[i] = silu_f(r1[i]); }
                    }
                    *(GAS u32x4*)(rowp + bj * HALF) = pack8(r0, r1);
                }
            }
    }
};

struct EpiOut {
    static constexpr bool PERM = false, AFTER_DRAIN = false;
    const GAS float* Xin; GAS float* Xout; const GAS float* gate;
    __device__ __forceinline__ void operator()(const f32x4 (&acc)[2][2][4][2], const Unit& u, int wr, int wc, int fr, int fq) const {
        const int row0 = u.pm * BM + wr * 64 + fr, col0 = u.pn * BM + wc * 32 + 4 * fq;
        const GAS float* gp = gate + (size_t)(u.pm >> 3) * (3 * D) + col0;
        f32x4 gv[2][2];
#pragma unroll
        for (int bj = 0; bj < 2; ++bj)
#pragma unroll
            for (int n = 0; n < 2; ++n) gv[bj][n] = *(const GAS f32x4*)(gp + bj * HALF + n * 16);
#pragma unroll
        for (int ai = 0; ai < 2; ++ai)
#pragma unroll
            for (int m = 0; m < 4; ++m) {
                const size_t off = (size_t)(row0 + ai * HALF + m * 16) * D + col0;
#pragma unroll
                for (int bj = 0; bj < 2; ++bj)
#pragma unroll
                    for (int n = 0; n < 2; ++n) { const f32x4 xo = *(const GAS f32x4*)(Xin + off + bj * HALF + n * 16); *(GAS f32x4*)(Xout + off + bj * HALF + n * 16) = xo + gv[bj][n] * acc[ai][bj][m][n]; }
            }
    }
};

template <class Epi, class Sched, bool ALIGN_EPI = false, bool SP2 = false>
__device__ __forceinline__ void gemm_phase(PG8_LAS unsigned char* lds, const Gemm g, const Sched& S, const Epi& E) {
    int tid_ = threadIdx.x; asm volatile("" : "+v"(tid_));
    const int tid = tid_, wid = __builtin_amdgcn_readfirstlane(tid >> 6), lane = tid & 63, wr = wid >> 2, wc = wid & 3, fr = lane & 15, fq = lane >> 4;
    const int K = g.K, nt = K / BK;
    unsigned voffA[2], voffB[2];
#pragma unroll
    for (int i = 0; i < 2; ++i) { int R, C; stage_rc(tid * 16 + i * 8192, R, C); const int Rb = Epi::PERM ? ((R & ~31) + perm32(R & 31)) : R;
        voffA[i] = (unsigned)(R * K + C) * 2u; voffB[i] = (unsigned)(Rb * K + C) * 2u; }
    const size_t kstep = (size_t)(BK * 2);
    const size_t hstep = (size_t)HALF * K * 2;
    const size_t tstep = 2 * hstep;
    const unsigned ldsw = (unsigned)wid * 1024u;
    const int aoff = lds_byte(wr * 64 + fr, fq * 8), boff = lds_byte(wc * 32 + fr, fq * 8);
#define PG8_SA(b, h) (((b) * 2 + (h)) * HTB)
#define PG8_SB(b, h) ((4 + (b) * 2 + (h)) * HTB)
#define PG8_STAGE(bufoff, gbase, voff) do { _Pragma("unroll") for (int _i = 0; _i < 2; ++_i) \
        __builtin_amdgcn_global_load_lds((const unsigned*)((const char*)(gbase) + (voff)[_i]), (PG8_LAS unsigned*)(lds + (bufoff) + ldsw + _i * 8192), 16, 0, 0); } while (0)
#define PG8_LDA(dst, b, h) do { _Pragma("unroll") for (int m = 0; m < 4; ++m) _Pragma("unroll") for (int k = 0; k < 2; ++k) dst[m][k] = *(const PG8_LAS bf16x8*)(lds + PG8_SA(b, h) + aoff + m * 2048 + k * 1024); } while (0)
#define PG8_LDB(dst, b, h) do { _Pragma("unroll") for (int n = 0; n < 2; ++n) _Pragma("unroll") for (int k = 0; k < 2; ++k) dst[n][k] = *(const PG8_LAS bf16x8*)(lds + PG8_SB(b, h) + boff + n * 2048 + k * 1024); } while (0)
#define PG8_MMA(ai, bj, At, Bt) do { __builtin_amdgcn_s_setprio(1); _Pragma("unroll") for (int m = 0; m < 4; ++m) _Pragma("unroll") for (int n = 0; n < 2; ++n) _Pragma("unroll") for (int k = 0; k < 2; ++k) \
        acc[ai][bj][m][n] = __builtin_amdgcn_mfma_f32_16x16x32_bf16(Bt[n][k], At[m][k], acc[ai][bj][m][n], 0, 0, 0); __builtin_amdgcn_s_setprio(0); } while (0)
#define PG8_WAIT_V(n) asm volatile("s_waitcnt vmcnt(" #n ")" ::: "memory")
#define PG8_WAIT_L(n) asm volatile("s_waitcnt lgkmcnt(" #n ")" ::: "memory")
#define PG8_BAR __builtin_amdgcn_s_barrier()
#define PG8_SCHED __builtin_amdgcn_sched_barrier(0)
    Unit cur, nxt; int ui = 0;
    if (!S.next(0, cur)) return;
    f32x4 acc[2][2][4][2];
#pragma unroll
    for (int a = 0; a < 2; ++a)
#pragma unroll
        for (int b = 0; b < 2; ++b)
#pragma unroll
            for (int m = 0; m < 4; ++m)
#pragma unroll
                for (int n = 0; n < 2; ++n) acc[a][b][m][n] = (f32x4){0.f, 0.f, 0.f, 0.f};
    bf16x8 At[4][2], B0[2][2], B1[2][2];
    const char* cA = (const char*)g.A + (size_t)cur.pm * tstep; const char* cB = (const char*)g.Bt + (size_t)cur.pn * tstep;
    S.a_ready(cur);
    if constexpr (SP2) {
        PG8_STAGE(PG8_SB(0, 0), cB, voffB); PG8_STAGE(PG8_SB(0, 1), cB + hstep, voffB); PG8_STAGE(PG8_SA(0, 0), cA, voffA); PG8_STAGE(PG8_SA(0, 1), cA + hstep, voffA);
        if (wr == 1) PG8_BAR;
        PG8_WAIT_V(2); PG8_BAR;
        PG8_STAGE(PG8_SB(1, 0), cB + kstep, voffB); PG8_STAGE(PG8_SA(1, 0), cA + kstep, voffA); PG8_STAGE(PG8_SB(1, 1), cB + hstep + kstep, voffB);
        PG8_WAIT_V(6); PG8_BAR;
    } else {
        PG8_STAGE(PG8_SB(0, 0), cB, voffB); PG8_STAGE(PG8_SA(0, 0), cA, voffA); PG8_STAGE(PG8_SB(0, 1), cB + hstep, voffB); PG8_STAGE(PG8_SA(0, 1), cA + hstep, voffA);
        if (wr == 1) PG8_BAR;
        PG8_WAIT_V(4); PG8_BAR;
        PG8_STAGE(PG8_SB(1, 0), cB + kstep, voffB); PG8_STAGE(PG8_SA(1, 0), cA + kstep, voffA); PG8_STAGE(PG8_SB(1, 1), cB + hstep + kstep, voffB);
        PG8_WAIT_V(6); PG8_BAR;
    }
    for (;;) {
        const bool has_next = S.next(ui + 1, nxt);
        const char* nA = has_next ? (const char*)g.A + (size_t)nxt.pm * tstep : cA; const char* nB = has_next ? (const char*)g.Bt + (size_t)nxt.pn * tstep : cB;
        for (int t = 0; t < nt; t += 2) {
            const bool last = (t == nt - 2);
            const char* a1 = cA + (size_t)(t + 1) * kstep;
            const char* a2 = last ? nA : cA + (size_t)(t + 2) * kstep; const char* b2 = last ? nB : cB + (size_t)(t + 2) * kstep;
            const char* a3 = a2 + kstep; const char* b3 = b2 + kstep;
            if (last && has_next) S.a_ready(nxt);
            if constexpr (SP2) {
            PG8_LDB(B0, 0, 0); PG8_LDB(B1, 0, 1); PG8_SCHED; PG8_LDA(At, 0, 0); PG8_STAGE(PG8_SA(1, 1), a1 + hstep, voffA);
            PG8_WAIT_V(8); PG8_WAIT_L(0); PG8_BAR; PG8_MMA(0, 0, At, B0); PG8_MMA(0, 1, At, B1); PG8_BAR; PG8_SCHED;
            PG8_LDA(At, 0, 1); PG8_STAGE(PG8_SB(0, 0), b2, voffB); PG8_STAGE(PG8_SB(0, 1), b2 + hstep, voffB); PG8_STAGE(PG8_SA(0, 0), a2, voffA);
            PG8_WAIT_V(8); PG8_WAIT_L(0); PG8_BAR; PG8_MMA(1, 0, At, B0); PG8_MMA(1, 1, At, B1); PG8_BAR; PG8_SCHED;
            PG8_LDB(B0, 1, 0); PG8_LDB(B1, 1, 1); PG8_SCHED; PG8_LDA(At, 1, 0); PG8_STAGE(PG8_SA(0, 1), a2 + hstep, voffA);
            PG8_WAIT_V(8); PG8_WAIT_L(0); PG8_BAR; PG8_MMA(0, 0, At, B0); PG8_MMA(0, 1, At, B1); PG8_BAR; PG8_SCHED;
            PG8_LDA(At, 1, 1); PG8_STAGE(PG8_SB(1, 0), b3, voffB); PG8_STAGE(PG8_SB(1, 1), b3 + hstep, voffB); PG8_STAGE(PG8_SA(1, 0), a3, voffA);
            PG8_WAIT_V(8); PG8_WAIT_L(0); PG8_BAR; PG8_MMA(1, 0, At, B0); PG8_MMA(1, 1, At, B1); PG8_BAR; PG8_SCHED;
            } else {
            PG8_LDB(B0, 0, 0); PG8_SCHED; PG8_LDA(At, 0, 0); PG8_STAGE(PG8_SA(1, 1), a1 + hstep, voffA);
            PG8_WAIT_L(8); PG8_BAR; PG8_WAIT_L(0); PG8_MMA(0, 0, At, B0); PG8_BAR; PG8_SCHED;
            PG8_LDB(B1, 0, 1); PG8_STAGE(PG8_SB(0, 0), b2, voffB);
            PG8_BAR; PG8_WAIT_L(0); PG8_MMA(0, 1, At, B1); PG8_BAR;
            PG8_LDA(At, 0, 1); PG8_STAGE(PG8_SA(0, 0), a2, voffA);
            PG8_BAR; PG8_WAIT_L(0); PG8_MMA(1, 0, At, B0); PG8_BAR; PG8_SCHED;
            PG8_STAGE(PG8_SB(0, 1), b2 + hstep, voffB);
            PG8_WAIT_V(6); PG8_BAR; PG8_MMA(1, 1, At, B1); PG8_BAR;
            PG8_LDB(B0, 1, 0); PG8_SCHED; PG8_LDA(At, 1, 0); PG8_STAGE(PG8_SA(0, 1), a2 + hstep, voffA);
            PG8_WAIT_L(8); PG8_BAR; PG8_WAIT_L(0); PG8_MMA(0, 0, At, B0); PG8_BAR; PG8_SCHED;
            PG8_LDB(B1, 1, 1); PG8_STAGE(PG8_SB(1, 0), b3, voffB);
            PG8_BAR; PG8_WAIT_L(0); PG8_MMA(0, 1, At, B1); PG8_BAR;
            PG8_LDA(At, 1, 1); PG8_STAGE(PG8_SA(1, 0), a3, voffA);
            PG8_BAR; PG8_WAIT_L(0); PG8_MMA(1, 0, At, B0); PG8_BAR; PG8_SCHED;
            PG8_STAGE(PG8_SB(1, 1), b3 + hstep, voffB);
            PG8_WAIT_V(6); PG8_BAR; PG8_MMA(1, 1, At, B1); PG8_BAR;
            }
        }
        if constexpr (ALIGN_EPI) { if (wr == 0) PG8_BAR; }
        if constexpr (!Epi::AFTER_DRAIN) { E(acc, cur, wr, wc, fr, fq); S.done(cur); }
        if (!has_next) break;
#pragma unroll
        for (int a = 0; a < 2; ++a)
#pragma unroll
            for (int b = 0; b < 2; ++b)
#pragma unroll
                for (int m = 0; m < 4; ++m)
#pragma unroll
                    for (int n = 0; n < 2; ++n) acc[a][b][m][n] = (f32x4){0.f, 0.f, 0.f, 0.f};
        cur = nxt; cA = nA; cB = nB; ++ui;
        if constexpr (ALIGN_EPI) { if (wr == 1) PG8_BAR; }
    }
    PG8_WAIT_V(0);
    if constexpr (!ALIGN_EPI) { if (wr == 0) PG8_BAR; }
    PG8_BAR;
    if constexpr (Epi::AFTER_DRAIN) { E.fused(acc, cur, wr, wc, fr, fq, lds, wid, lane); S.done(cur); }
#undef PG8_SA
#undef PG8_SB
#undef PG8_STAGE
#undef PG8_LDA
#undef PG8_LDB
#undef PG8_MMA
#undef PG8_WAIT_V
#undef PG8_WAIT_L
#undef PG8_BAR
#undef PG8_SCHED
}
}

constexpr size_t KiB = 1024, MiB = 1u << 20;
constexpr size_t WS_CTL = 0, CTL_ZERO_BYTES = 64 * KiB;
constexpr size_t WS_MOD = 64 * KiB;
constexpr size_t WS_ALR = 512 * KiB;
constexpr size_t WS_WAIN = 2 * MiB;
constexpr size_t WS_WAOUT = WS_WAIN + (size_t)2 * A_IN * D * 2;
constexpr size_t WS_WBIN = WS_WAOUT + (size_t)2 * D * DI * 2;
constexpr size_t WS_WBOUT = WS_WBIN + (size_t)2 * B_INW * D * 2;
constexpr size_t WS_WEND = WS_WBOUT + (size_t)2 * D * DI * 2;
constexpr size_t WS_H = 63 * MiB;
constexpr size_t WS_R = 95 * MiB;
constexpr size_t WS_END = 255 * MiB;
static_assert(WS_WEND <= WS_H, "weights overflow");
constexpr size_t WS_UZ = WS_R, WS_GV = WS_R + 64 * MiB, WS_SSQA = WS_R + 128 * MiB;
constexpr size_t WS_Q = WS_R, WS_K = WS_R + 16 * MiB, WS_V = WS_R + 32 * MiB, WS_SZ = WS_R + 96 * MiB;
constexpr size_t WS_SSQB = WS_H;
constexpr size_t WS_DEC = WS_H + 2 * MiB;
constexpr size_t WS_LA = WS_H;
constexpr int CW_BAR = 1024;

constexpr int RING_BYTES = 131072;
constexpr int LDSCTL_OFF = RING_BYTES, MISC_OFF = LDSCTL_OFF + 320;
constexpr int LDS_BYTES = 147456;
constexpr int NWAVES = 8, NTHREADS = 512;

#define LDS_WAIT() asm volatile("s_waitcnt lgkmcnt(0)" ::: "memory")
#define VM_WAIT() asm volatile("s_waitcnt vmcnt(0)" ::: "memory")

#define XB_TMO      128
#define XB_XCNT(j)  (256  + 64 * (j))
#define XB_XSUB(j)  (1280 + 64 * (j))
#define XB_XGEN(j)  (2304 + 64 * (j))
#define XB_TOP      3328
#define XB_TOPGEN   3392
#define XCD_BAR_WORDS 3456
#define XB_SPIN_CAP (1u << 18)

__device__ __forceinline__ unsigned xb_ld(unsigned* p)              { return __hip_atomic_load(p, __ATOMIC_RELAXED, __HIP_MEMORY_SCOPE_AGENT); }
__device__ __forceinline__ unsigned xb_add(unsigned* p, unsigned v) { return __hip_atomic_fetch_add(p, v, __ATOMIC_RELAXED, __HIP_MEMORY_SCOPE_AGENT); }
__device__ __forceinline__ unsigned xb_xcc_id() { return (unsigned)__builtin_amdgcn_s_getreg((3 << 11) | 20) & 0xFu; }
#define XB_SPIN(cond, bar) do { unsigned _sp = 0; while (cond) { __builtin_amdgcn_s_sleep(1); \
    if ((++_sp & 255u) == 0u) { if (xb_ld(&(bar)[XB_TMO])) break; if (_sp > XB_SPIN_CAP) { atomicAdd(&(bar)[XB_TMO], 1u); break; } } } } while (0)

struct XcdBarrier {
    unsigned* bar; unsigned x;
    volatile LAS unsigned* st;
};

__device__ __forceinline__ XcdBarrier xcd_barrier_post(unsigned* bar, volatile LAS unsigned* st) {
    XcdBarrier b; b.bar = bar; b.x = xb_xcc_id(); b.st = st;
    if (threadIdx.x == 0) (void)xb_add(&bar[XB_XCNT(b.x)], 1u);
    return b;
}
__device__ __forceinline__ void xcd_barrier_complete(unsigned* bar, unsigned x, unsigned& nloc, unsigned& nx) {
    const unsigned G = gridDim.x * gridDim.y * gridDim.z;
    unsigned sum, cnt, mine, sp = 0u;
    for (;;) {
        sum = 0u; cnt = 0u; mine = 0u;
#pragma unroll
        for (unsigned j = 0; j < 16; ++j) { const unsigned c = xb_ld(&bar[XB_XCNT(j)]); sum += c; cnt += (c > 0u) ? 1u : 0u; mine = (j == x) ? c : mine; }
        if (sum == G) break;
        __builtin_amdgcn_s_sleep(1);
        if ((++sp & 255u) == 0u) { if (xb_ld(&bar[XB_TMO])) break; if (sp > XB_SPIN_CAP) { atomicAdd(&bar[XB_TMO], 1u); break; } }
    }
    nloc = mine > 0u ? mine : 1u; nx = cnt > 0u ? cnt : 1u;
}

__device__ __forceinline__ void xcd_barrier(const XcdBarrier& b) {
    asm volatile("s_waitcnt vmcnt(0)" ::: "memory");
    __syncthreads();
    if (threadIdx.x == 0) {
        unsigned* bar = b.bar;
        __builtin_amdgcn_s_waitcnt(0);
        unsigned nloc = b.st[0], nx = b.st[1];
        if (nloc == 0u) { xcd_barrier_complete(bar, b.x, nloc, nx); b.st[0] = nloc; b.st[1] = nx; }
        const unsigned old = xb_add(&bar[XB_XSUB(b.x)], 1u);
        const unsigned gen = old / nloc;
        if (old + 1u == (gen + 1u) * nloc) {
            __builtin_amdgcn_fence(__ATOMIC_RELEASE, "agent");
            asm volatile("s_waitcnt vmcnt(0)" ::: "memory");
            const unsigned og = xb_add(&bar[XB_TOP], 1u);
            const unsigned tg = og / nx;
            if (og + 1u == (tg + 1u) * nx) xb_add(&bar[XB_TOPGEN], 1u);
            else XB_SPIN(xb_ld(&bar[XB_TOPGEN]) == tg, bar);
            __builtin_amdgcn_fence(__ATOMIC_ACQUIRE, "agent");
            xb_add(&bar[XB_XGEN(b.x)], 1u);
            asm volatile("s_waitcnt vmcnt(0)" ::: "memory");
        } else {
            XB_SPIN(xb_ld(&bar[XB_XGEN(b.x)]) == gen, bar);
            __builtin_amdgcn_fence(__ATOMIC_ACQUIRE, "agent");
            asm volatile("s_waitcnt vmcnt(0)" ::: "memory");
        }
    }
    __syncthreads();
}


struct Frame {
    LAS unsigned char* lds;
    int tid, lane, wave, vcu, G;
    const GAS float *x, *c, *w_ada, *b_ada, *g_norm, *a_w_in, *a_w_s, *a_b_s, *a_g_v, *a_w_out, *b_w_in, *b_w_gate_up, *b_b_gate, *b_g_o, *b_w_out, *g_final;
    GAS float* out; GAS unsigned char* ws;
};

__device__ __forceinline__ void p0_transpose_item(const GAS float* W, int K, int N, GAS bf16* WT, int k0, int n0, int drow0, LAS float* scr, int lane) {
    const int nn = n0 + (lane & 31); const bool okl = nn < N;
#pragma unroll 8
    for (int i = 0; i < 32; ++i) { const int kk = 2 * i + (lane >> 5); scr[kk * 33 + (lane & 31)] = okl ? W[(size_t)(k0 + kk) * N + nn] : 0.f; }
    LDS_WAIT(); asm volatile("" ::: "memory");
    const int c = lane & 7;
#pragma unroll
    for (int j = 0; j < 4; ++j) { const int n = (lane >> 3) + 8 * j; const LAS float* s = scr + (8 * c) * 33 + n;
        v4u o; o.x = pk2(s[0 * 33], s[1 * 33]); o.y = pk2(s[2 * 33], s[3 * 33]); o.z = pk2(s[4 * 33], s[5 * 33]); o.w = pk2(s[6 * 33], s[7 * 33]);
        if (n0 + n < N) *(GAS v4u*)(WT + (size_t)(drow0 + n) * K + k0 + 8 * c) = o; }
    LDS_WAIT(); asm volatile("" ::: "memory");
}
__device__ __forceinline__ int map_a_in(int c) {
    if (c < DI) return (c >> 7) * 256 + (c & 127);
    if (c < 2 * DI) return 4096 + (c - DI);
    const int cz = c - 2 * DI; return (cz >> 7) * 256 + 128 + (cz & 127);
}
__device__ __forceinline__ void p0_prologue(Frame& F) {
    {
        LAS float* sc = (LAS float*)F.lds;
        LAS float* red = (LAS float*)(F.lds + 32768);
        for (int it = F.vcu; it < 4 * 48; it += F.G) {
            for (int i = F.tid; i < BATCH * D; i += NTHREADS) sc[i] = silu_f(F.c[i]);
            __syncthreads();
            const int l = it / 48, n0 = (it % 48) * 64;
            const GAS float* W = F.w_ada + (size_t)l * D * (3 * D) + n0 + F.lane;
            float acc[8];
#pragma unroll
            for (int b = 0; b < 8; ++b) acc[b] = 0.f;
            const int kb = F.wave * 128;
#pragma unroll 8
            for (int k = 0; k < 128; ++k) { const float w = W[(size_t)(kb + k) * (3 * D)];
#pragma unroll
                for (int b = 0; b < 8; ++b) acc[b] += sc[b * D + kb + k] * w; }
#pragma unroll
            for (int b = 0; b < 8; ++b) red[(F.wave * 8 + b) * 64 + F.lane] = acc[b];
            __syncthreads();
            { const int b = F.tid >> 6, n = F.tid & 63; float s = F.b_ada[l * 3 * D + n0 + n];
#pragma unroll
              for (int w = 0; w < 8; ++w) s += red[(w * 8 + b) * 64 + n];
              ((GAS float*)(F.ws + WS_MOD))[((size_t)l * BATCH + b) * (3 * D) + n0 + n] = s; }
            __syncthreads();
        }
    }
    LAS float* scr = (LAS float*)(F.lds + F.wave * 16384);
    const int gw = F.vcu * NWAVES + F.wave, NGW = F.G * NWAVES;
    constexpr int NB_AIN = A_IN / 32, NB_BIN = (B_INW + 31) / 32, NB_OUT = D / 32;
    constexpr int I_AIN = (D / 64) * NB_AIN, I_AOUT = (DI / 64) * NB_OUT, I_BIN = (D / 64) * NB_BIN, I_BOUT = I_AOUT;
    constexpr int I_LAYER = I_AIN + I_AOUT + I_BIN + I_BOUT;
    for (int it = gw; it < 2 * I_LAYER; it += NGW) {
        const int j = it / I_LAYER; int r = it % I_LAYER;
        if (r < I_AIN) { const int kb = r / NB_AIN, nb = r % NB_AIN;
            p0_transpose_item(F.a_w_in + (size_t)j * D * A_IN, D, A_IN, (GAS bf16*)(F.ws + WS_WAIN) + (size_t)j * A_IN * D, 64 * kb, 32 * nb, map_a_in(32 * nb), scr, F.lane); continue; } r -= I_AIN;
        if (r < I_AOUT) { const int kb = r / NB_OUT, nb = r % NB_OUT;
            p0_transpose_item(F.a_w_out + (size_t)j * DI * D, DI, D, (GAS bf16*)(F.ws + WS_WAOUT) + (size_t)j * D * DI, 64 * kb, 32 * nb, 32 * nb, scr, F.lane); continue; } r -= I_AOUT;
        if (r < I_BIN) { const int kb = r / NB_BIN, nb = r % NB_BIN;
            p0_transpose_item(F.b_w_in + (size_t)j * D * B_INW, D, B_INW, (GAS bf16*)(F.ws + WS_WBIN) + (size_t)j * B_INW * D, 64 * kb, 32 * nb, 32 * nb, scr, F.lane); continue; } r -= I_BIN;
        { const int kb = r / NB_OUT, nb = r % NB_OUT;
            p0_transpose_item(F.b_w_out + (size_t)j * DI * D, DI, D, (GAS bf16*)(F.ws + WS_WBOUT) + (size_t)j * D * DI, 64 * kb, 32 * nb, 32 * nb, scr, F.lane); }
    }
}

__device__ __forceinline__ void h_pass(Frame& F, const GAS float* X, int layer) {
    const int gw = F.vcu * NWAVES + F.wave;
    const int rows_per = M / (F.G * NWAVES);
    const int r0 = gw * rows_per, b = r0 / SEQ;
    const GAS float* mod = (const GAS float*)(F.ws + WS_MOD) + ((size_t)layer * BATCH + b) * (3 * D);
    f32x4 gs[4], sh[4];
#pragma unroll
    for (int j = 0; j < 4; ++j) { const int k = 4 * F.lane + 256 * j; const f32x4 g = *(const GAS f32x4*)(F.g_norm + layer * D + k); const f32x4 sc = *(const GAS f32x4*)(mod + D + k);
        sh[j] = *(const GAS f32x4*)(mod + k); gs[j] = g * (sc + 1.0f); }
    GAS bf16* Hb = (GAS bf16*)(F.ws + WS_H);
    for (int r = r0; r < r0 + rows_per; ++r) {
        const GAS f32x4* xr = (const GAS f32x4*)(X + (size_t)r * D) + F.lane;
        f32x4 v[4]; float s = 0.f;
#pragma unroll
        for (int j = 0; j < 4; ++j) { v[j] = xr[64 * j]; s += (v[j].x * v[j].x + v[j].y * v[j].y) + (v[j].z * v[j].z + v[j].w * v[j].w); }
        const float rinv = 1.0f / sqrtf(wave_sum(s) * (1.f / D) + EPS);
        GAS v2u* o8 = (GAS v2u*)(Hb + (size_t)r * D) + F.lane;
#pragma unroll
        for (int j = 0; j < 4; ++j) { const f32x4 h = v[j] * rinv * gs[j] + sh[j]; v2u w; w.x = pk2(h.x, h.y); w.y = pk2(h.z, h.w); o8[64 * j] = w; }
    }
}
__device__ __forceinline__ void final_norm(Frame& F, GAS float* X) {
    const int gw = F.vcu * NWAVES + F.wave, rows_per = M / (F.G * NWAVES), r0 = gw * rows_per;
    f32x4 g[4];
#pragma unroll
    for (int j = 0; j < 4; ++j) g[j] = *(const GAS f32x4*)(F.g_final + 4 * F.lane + 256 * j);
    for (int r = r0; r < r0 + rows_per; ++r) {
        GAS f32x4* xr = (GAS f32x4*)(X + (size_t)r * D) + F.lane;
        f32x4 v[4]; float s = 0.f;
#pragma unroll
        for (int j = 0; j < 4; ++j) { v[j] = xr[64 * j]; s += (v[j].x * v[j].x + v[j].y * v[j].y) + (v[j].z * v[j].z + v[j].w * v[j].w); }
        const float rinv = 1.0f / sqrtf(wave_sum(s) * (1.f / D) + EPS);
#pragma unroll
        for (int j = 0; j < 4; ++j) xr[64 * j] = v[j] * rinv * g[j];
    }
}

__device__ __forceinline__ void alr_phase(Frame& F, int j) {
    const GAS bf16* Hb = (const GAS bf16*)(F.ws + WS_H);
    const GAS bf16* Wt = (const GAS bf16*)(F.ws + WS_WBIN) + ((size_t)j * B_INW + B_N) * D;
    GAS float* ALR = (GAS float*)(F.ws + WS_ALR);
    LAS f32x4* red = (LAS f32x4*)F.lds;
    const int rows_per = M / F.G;
    const int r0 = F.vcu * rows_per, mt = F.wave & 3, kh = F.wave >> 2, fr = F.lane & 15, fq = F.lane >> 4;
    const GAS bf16* ap = Hb + (size_t)(r0 + mt * 16 + fr) * D + kh * 512 + fq * 8;
    const GAS bf16* bp = Wt + (size_t)fr * D + kh * 512 + fq * 8;
    f32x4 acc = {0.f, 0.f, 0.f, 0.f};
#pragma unroll 4
    for (int ks = 0; ks < 16; ++ks) {
        const bf16x8 a = *(const GAS bf16x8*)(ap + ks * 32), b = *(const GAS bf16x8*)(bp + ks * 32);
        acc = __builtin_amdgcn_mfma_f32_16x16x32_bf16(b, a, acc, 0, 0, 0);
    }
    if (kh == 1) red[mt * 64 + F.lane] = acc;
    __syncthreads();
    if (kh == 0) { acc = acc + red[mt * 64 + F.lane]; *(GAS f32x4*)(ALR + (size_t)(r0 + mt * 16 + fr) * GRANK + 4 * fq) = acc; }
    __syncthreads();
}


#if NAIVE_MIX
__global__ void __launch_bounds__(256) naive_mix(const bf16* GV, bf16* UZ, const float* ssq, const float* w_s, const float* b_s, const float* g_v) {
    __shared__ float rinv[128];
    const int c = blockIdx.x >> 3, g = blockIdx.x & 7, d = threadIdx.x, r0 = c * 128;
    if (d < 128) { float s = 0.f; for (int i = 0; i < 32; ++i) s += ssq[(size_t)(r0 + d) * 32 + i]; rinv[d] = 1.0f / sqrtf(s * (1.f / DI) + EPS); }
    __syncthreads();
    const float gvd = g_v[g * 256 + d];
    for (int t = 0; t < 128; ++t) {
        float acc = 0.f;
        for (int s = 0; s <= t; ++s) acc += w_s[(size_t)(g * 128 + t) * 128 + s] * rinv[s] * bf2f(GV[(size_t)(r0 + s) * DI + g * 256 + d]);
        const float mixed = acc * gvd + b_s[g * 128 + t];
        const size_t idx = (size_t)(r0 + t) * DI + g * 256 + d;
        UZ[idx] = (bf16)f2bf(mixed * bf2f(UZ[idx]));
    }
}
#endif
#if NAIVE_GLA
__global__ void __launch_bounds__(256) naive_la(const float* ALR, const float* wg, const float* bg, float* LA) {
    const size_t idx = (size_t)blockIdx.x * 256 + threadIdx.x; const int row = (int)(idx >> 9), kk = (int)(idx & 511);
    float g = bg[kk];
    for (int i = 0; i < GRANK; ++i) g += ALR[(size_t)row * GRANK + i] * wg[i * 512 + kk];
    const float ls = fminf(g, 0.f) - log1pf(expf(-fabsf(g)));
    LA[idx] = ls * (1.f / 16.f);
}
__global__ void __launch_bounds__(256) naive_scan(const bf16* Q, const bf16* Kk, bf16* V, const float* LA) {
    __shared__ float red[4][64];
    const int b = blockIdx.x >> 5, h = (blockIdx.x >> 3) & 3, vb = blockIdx.x & 7, kq = threadIdx.x >> 6, vv = threadIdx.x & 63;
    float S[32];
#pragma unroll
    for (int i = 0; i < 32; ++i) S[i] = 0.f;
    for (int t = 0; t < SEQ; ++t) {
        const size_t row = (size_t)b * SEQ + t; const size_t vidx = row * DI + h * 512 + vb * 64 + vv;
        const float v = bf2f(V[vidx]); float part = 0.f;
        const size_t kb = row * 512 + h * 128 + kq * 32;
#pragma unroll
        for (int i = 0; i < 32; ++i) { const float a = expf(LA[kb + i]); S[i] = a * S[i] + bf2f(Kk[kb + i]) * v; part += bf2f(Q[kb + i]) * S[i]; }
        red[kq][vv] = part;
        __syncthreads();
        if (kq == 0) V[vidx] = (bf16)f2bf(red[0][vv] + red[1][vv] + red[2][vv] + red[3][vv]);
        __syncthreads();
    }
}
__global__ void __launch_bounds__(256) naive_gla_norm(const bf16* O, bf16* SZ, const float* g_o) {
    const size_t row = blockIdx.x; const int h = threadIdx.x >> 6, l = threadIdx.x & 63;
    float o[8]; float s = 0.f;
#pragma unroll
    for (int i = 0; i < 8; ++i) { o[i] = bf2f(O[row * DI + h * 512 + l * 8 + i]); s += o[i] * o[i]; }
    s = wave_sum(s);
    const float rinv = 1.0f / sqrtf(s * (1.f / GDV) + EPS);
#pragma unroll
    for (int i = 0; i < 8; ++i) { const size_t idx = row * DI + h * 512 + l * 8 + i; SZ[idx] = (bf16)f2bf(o[i] * rinv * g_o[l * 8 + i] * bf2f(SZ[idx])); }
}
#endif

typedef short s16x4 __attribute__((ext_vector_type(4)));
__device__ __forceinline__ bf16x8 cat4(s16x4 a, s16x4 b) { return __builtin_shufflevector(a, b, 0, 1, 2, 3, 4, 5, 6, 7); }
__device__ __forceinline__ unsigned lds_u32(const LAS unsigned char* p) { return (unsigned)(uintptr_t)p; }
template <int O0, int O1, int O2, int O3>
__device__ __forceinline__ void tr4(unsigned base, s16x4& r0, s16x4& r1, s16x4& r2, s16x4& r3) {
    asm volatile("ds_read_b64_tr_b16 %0, %4 offset:%5\n\tds_read_b64_tr_b16 %1, %4 offset:%6\n\tds_read_b64_tr_b16 %2, %4 offset:%7\n\tds_read_b64_tr_b16 %3, %4 offset:%8\n\ts_waitcnt lgkmcnt(0)"
                 : "=&v"(r0), "=&v"(r1), "=&v"(r2), "=&v"(r3) : "v"(base), "i"(O0), "i"(O1), "i"(O2), "i"(O3) : "memory");
}
__device__ __forceinline__ f32x4 unpk_lo(v2u w) { return (f32x4){bflo(w.x), bfhi(w.x), bflo(w.y), bfhi(w.y)}; }

constexpr int MX_WSTR = 272, MX_GSTR = 576, MX_WM = 0, MX_GV = 128 * MX_WSTR, MX_RINV = MX_GV + 128 * MX_GSTR;
static_assert(MX_RINV + 512 <= RING_BYTES, "mix LDS");
template <int KS>
__device__ __forceinline__ void mix_kstep(const LAS unsigned char* lds, unsigned trbase, int fr, int fq, f32x4 (&acc)[2][8]) {
    s16x4 a00, a01, a10, a11;
    tr4<KS * 32 * MX_GSTR, KS * 32 * MX_GSTR + 4 * MX_GSTR, KS * 32 * MX_GSTR + 8, KS * 32 * MX_GSTR + 4 * MX_GSTR + 8>(trbase, a00, a01, a10, a11);
    __builtin_amdgcn_sched_barrier(0);
    const bf16x8 A0 = cat4(a00, a01), A1 = cat4(a10, a11);
#pragma unroll
    for (int tt = 0; tt < 8; ++tt) {
        if (2 * KS <= tt) {
            const bf16x8 B = *(const LAS bf16x8*)(lds + MX_WM + (16 * tt + fr) * MX_WSTR + 64 * KS + 16 * fq);
            acc[0][tt] = __builtin_amdgcn_mfma_f32_16x16x32_bf16(A0, B, acc[0][tt], 0, 0, 0);
            acc[1][tt] = __builtin_amdgcn_mfma_f32_16x16x32_bf16(A1, B, acc[1][tt], 0, 0, 0);
        }
    }
}
__device__ __forceinline__ void mix_phase(Frame& F, int j, bool dummy = false) {
    const GAS bf16* GV = (const GAS bf16*)(F.ws + WS_GV); GAS bf16* UZ = (GAS bf16*)(F.ws + WS_UZ); GAS bf16* YO = dummy ? (GAS bf16*)(F.ws + WS_H) : UZ; const int rmask = dummy ? 8191 : 0x7fffffff; const GAS float* ssq = (const GAS float*)(F.ws + WS_SSQA);
    const GAS float* w_s = F.a_w_s + (size_t)j * SGU_G * SGU_T * SGU_T; const GAS float* b_s = F.a_b_s + (size_t)j * SGU_G * SGU_T; const GAS float* g_v = F.a_g_v + (size_t)j * DI;
    const int tid = F.tid, lane = F.lane, w = F.wave, fr = lane & 15, fq = lane >> 4;
    LAS float* rinv = (LAS float*)(F.lds + MX_RINV);
    const unsigned trbase = lds_u32(F.lds + MX_GV) + (unsigned)((8 * fq + (fr >> 2)) * MX_GSTR + (32 * w + 8 * (lane & 3)) * 2);
    for (int u = blockIdx.x; u < 128 * SGU_G; u += F.G) {
        const int c = u >> 3, g = u & 7, r0 = c * 128;
        const int row = tid >> 5, ch = tid & 31;
        v4u gvr[8]; f32x4 wr[8];
#pragma unroll
        for (int i = 0; i < 8; ++i) gvr[i] = *(const GAS v4u*)(GV + (size_t)(r0 + row + 16 * i) * DI + g * 256 + ch * 8);
#pragma unroll
        for (int i = 0; i < 8; ++i) wr[i] = *(const GAS f32x4*)(w_s + ((size_t)g * 128 + row + 16 * i) * 128 + ch * 4);
        if (tid < 128) { const GAS f32x4* p = (const GAS f32x4*)(ssq + (size_t)(r0 + tid) * 32); float s = 0.f;
#pragma unroll
            for (int i = 0; i < 8; ++i) { const f32x4 v = p[i]; s += (v.x + v.y) + (v.z + v.w); }
            rinv[tid] = 1.0f / sqrtf(s * (1.f / DI) + EPS); }
        __syncthreads();
        { const f32x4 ri = *(const LAS f32x4*)(rinv + ch * 4); const int s0 = ch * 4;
#pragma unroll
          for (int i = 0; i < 8; ++i) { const int t = row + 16 * i; f32x4 v = wr[i] * ri;
              v.x = (s0 <= t) ? v.x : 0.f; v.y = (s0 + 1 <= t) ? v.y : 0.f; v.z = (s0 + 2 <= t) ? v.z : 0.f; v.w = (s0 + 3 <= t) ? v.w : 0.f;
              v2u o; o.x = pk2(v.x, v.y); o.y = pk2(v.z, v.w);
              *(LAS v2u*)(F.lds + MX_WM + t * MX_WSTR + s0 * 2) = o;
              *(LAS v4u*)(F.lds + MX_GV + t * MX_GSTR + ch * 16) = gvr[i]; } }
        __syncthreads();
        const int dcol = g * 256 + 32 * w + 8 * fq;
        v4u uz[8];
#pragma unroll
        for (int tt = 0; tt < 8; ++tt) uz[tt] = *(const GAS v4u*)(UZ + (size_t)(r0 + 16 * tt + fr) * DI + dcol);
        f32x4 acc[2][8];
#pragma unroll
        for (int a = 0; a < 2; ++a)
#pragma unroll
            for (int tt = 0; tt < 8; ++tt) acc[a][tt] = (f32x4){0.f, 0.f, 0.f, 0.f};
        mix_kstep<0>(F.lds, trbase, fr, fq, acc); mix_kstep<1>(F.lds, trbase, fr, fq, acc); mix_kstep<2>(F.lds, trbase, fr, fq, acc); mix_kstep<3>(F.lds, trbase, fr, fq, acc);
        const f32x4 g0 = *(const GAS f32x4*)(g_v + dcol), g1 = *(const GAS f32x4*)(g_v + dcol + 4);
#pragma unroll
        for (int tt = 0; tt < 8; ++tt) {
            const float bs = b_s[g * 128 + 16 * tt + fr];
            const f32x4 y0 = (acc[0][tt] * g0 + bs) * unpk_lo((v2u){uz[tt].x, uz[tt].y}), y1 = (acc[1][tt] * g1 + bs) * unpk_lo((v2u){uz[tt].z, uz[tt].w});
            v4u o; o.x = pk2(y0.x, y0.y); o.y = pk2(y0.z, y0.w); o.z = pk2(y1.x, y1.y); o.w = pk2(y1.z, y1.w);
            *(GAS v4u*)(YO + (size_t)((r0 + 16 * tt + fr) & rmask) * DI + dcol) = o;
        }
    }
    __syncthreads();
}

__device__ __forceinline__ void gla_prep_phase(Frame& F, int j) {
    GAS bf16* Q = (GAS bf16*)(F.ws + WS_Q); GAS bf16* Kk = (GAS bf16*)(F.ws + WS_K); const GAS float* ALR = (const GAS float*)(F.ws + WS_ALR); GAS float* DEC = (GAS float*)(F.ws + WS_DEC);
    const GAS float* wg = F.b_w_gate_up + (size_t)j * GRANK * 512; const GAS float* bg = F.b_b_gate + (size_t)j * 512;
    LAS float* alr = (LAS float*)F.lds;
    LAS float* tot = (LAS float*)(F.lds + 4096);
    const int tid = F.tid, kp = tid & 63, ts = F.wave;
    for (int u = blockIdx.x; u < BATCH * GNC * GH; u += F.G) {
        const int h = u & 3, c = (u >> 2) & 31, b = u >> 7, r0 = b * SEQ + c * GL, col = h * GDK + 2 * kp;
        if (tid < 256) *(LAS f32x4*)(alr + tid * 4) = *(const GAS f32x4*)(ALR + (size_t)r0 * GRANK + tid * 4);
        unsigned qv[8], kv[8];
#pragma unroll
        for (int tt = 0; tt < 8; ++tt) { const size_t o = (size_t)(r0 + ts * 8 + tt) * 512 + col; qv[tt] = *(const GAS unsigned*)(Q + o); kv[tt] = *(const GAS unsigned*)(Kk + o); }
        f32x2 wv[16];
#pragma unroll
        for (int i = 0; i < 16; ++i) wv[i] = *(const GAS f32x2*)(wg + i * 512 + col);
        const f32x2 bgv = *(const GAS f32x2*)(bg + col);
        __syncthreads();
        f32x2 cs[8]; f32x2 run = {0.f, 0.f};
#pragma unroll
        for (int tt = 0; tt < 8; ++tt) {
            const LAS f32x4* ar = (const LAS f32x4*)(alr + (ts * 8 + tt) * 16);
            f32x2 g = bgv;
#pragma unroll
            for (int q4 = 0; q4 < 4; ++q4) { const f32x4 a = ar[q4]; g += wv[4 * q4] * a.x + wv[4 * q4 + 1] * a.y + wv[4 * q4 + 2] * a.z + wv[4 * q4 + 3] * a.w; }
            f32x2 la;
            la.x = (fminf(g.x, 0.f) - __logf(1.0f + __expf(-fabsf(g.x)))) * (1.f / 16.f);
            la.y = (fminf(g.y, 0.f) - __logf(1.0f + __expf(-fabsf(g.y)))) * (1.f / 16.f);
            run += la; cs[tt] = run;
        }
        *(LAS f32x2*)(tot + ts * 128 + 2 * kp) = run;
        __syncthreads();
        f32x2 pre = {0.f, 0.f}, all = {0.f, 0.f};
#pragma unroll
        for (int s = 0; s < 8; ++s) { const f32x2 t2 = *(const LAS f32x2*)(tot + s * 128 + 2 * kp); all += t2; if (s < ts) pre += t2; }
#pragma unroll
        for (int tt = 0; tt < 8; ++tt) {
            const f32x2 bb = pre + cs[tt];
            const float e0 = __expf(bb.x), e1 = __expf(bb.y), i0 = __expf(-bb.x), i1 = __expf(-bb.y);
            const size_t o = (size_t)(r0 + ts * 8 + tt) * 512 + col;
            *(GAS unsigned*)(Q + o) = pk2(bflo(qv[tt]) * e0, bfhi(qv[tt]) * e1);
            *(GAS unsigned*)(Kk + o) = pk2(bflo(kv[tt]) * i0, bfhi(kv[tt]) * i1);
        }
        if (ts == 0) { f32x2 d; d.x = __expf(all.x); d.y = __expf(all.y); *(GAS f32x2*)(DEC + (((size_t)b * GNC + c) * GH + h) * GDK + 2 * kp) = d; }
        __syncthreads();
    }
}

constexpr int SC_QSTR = 272, SC_VSTR = 144;
constexpr int SC_QD = 0, SC_KI = 64 * SC_QSTR, SC_V = 2 * 64 * SC_QSTR, SC_DEC = SC_V + 64 * SC_VSTR, SC_ATT = SC_DEC + 512, SC_OX = SC_ATT + 64 * SC_VSTR, SC_SSQ = SC_OX + 16384, SC_END = SC_SSQ + 1024;
static_assert(SC_END <= RING_BYTES && SC_OX % 16 == 0 && SC_ATT % 16 == 0 && SC_V % 16 == 0, "scan LDS");
__device__ __forceinline__ void gla_scan_phase(Frame& F, int j, bool dummy = false) {
    const GAS bf16* QD = (const GAS bf16*)(F.ws + WS_Q); const GAS bf16* KI = (const GAS bf16*)(F.ws + WS_K); const GAS bf16* V = (const GAS bf16*)(F.ws + WS_V); GAS bf16* SZ = (GAS bf16*)(F.ws + WS_SZ);
    GAS bf16* AO = dummy ? (GAS bf16*)(F.ws + WS_H + 4 * MiB) : SZ; const int rmask = dummy ? 4095 : 0x7fffffff;
    const GAS float* DEC = (const GAS float*)(F.ws + WS_DEC); GAS float* SSQB = (GAS float*)(F.ws + WS_SSQB); const GAS float* g_o = F.b_g_o + (size_t)j * GDV;
    const int tid = F.tid, lane = F.lane, w = F.wave, fr = lane & 15, fq = lane >> 4, vt = w & 3, hf = w >> 2;
    const int bid = blockIdx.x, bh = (bid & 7) * 4 + (bid >> 6), vs = (bid >> 3) & 7, b = bh >> 2, h = bh & 3;
    const LAS unsigned char* L = F.lds;
    const int qrow = tid >> 4, qch = tid & 15, vrow = tid >> 3, vch = tid & 7;
    const GAS bf16* qg = QD + (size_t)(b * SEQ + qrow) * 512 + h * GDK + qch * 8;
    const GAS bf16* kg = KI + (size_t)(b * SEQ + qrow) * 512 + h * GDK + qch * 8;
    const GAS bf16* vg = V + (size_t)(b * SEQ + vrow) * DI + h * GDV + vs * 64 + vch * 8;
    const GAS float* dg = DEC + ((size_t)b * GNC * GH + h) * GDK + (tid & 31) * 4;
    v4u sq0, sq1, sk0, sk1, sv; f32x4 sd = {0.f, 0.f, 0.f, 0.f};
#define SC_LOAD(c) do { const size_t ro = (size_t)(c) * GL; sq0 = *(const GAS v4u*)(qg + ro * 512); sq1 = *(const GAS v4u*)(qg + (ro + 32) * 512); sk0 = *(const GAS v4u*)(kg + ro * 512); sk1 = *(const GAS v4u*)(kg + (ro + 32) * 512); \
        sv = *(const GAS v4u*)(vg + ro * DI); if (tid < 32) sd = *(const GAS f32x4*)(dg + (size_t)(c) * GH * GDK); } while (0)
#define SC_STORE() do { *(LAS v4u*)(F.lds + SC_QD + qrow * SC_QSTR + qch * 16) = sq0; *(LAS v4u*)(F.lds + SC_QD + (qrow + 32) * SC_QSTR + qch * 16) = sq1; \
        *(LAS v4u*)(F.lds + SC_KI + qrow * SC_QSTR + qch * 16) = sk0; *(LAS v4u*)(F.lds + SC_KI + (qrow + 32) * SC_QSTR + qch * 16) = sk1; \
        *(LAS v4u*)(F.lds + SC_V + vrow * SC_VSTR + vch * 16) = sv; if (tid < 32) *(LAS f32x4*)(F.lds + SC_DEC + tid * 16) = sd; } while (0)
    f32x4 S[4];
#pragma unroll
    for (int i = 0; i < 4; ++i) S[i] = (f32x4){0.f, 0.f, 0.f, 0.f};
    SC_LOAD(0); SC_STORE();
    __syncthreads();
    const unsigned kibase = lds_u32(F.lds + SC_KI) + (unsigned)((8 * fq + (fr >> 2)) * SC_QSTR + (64 * hf + 4 * (lane & 3)) * 2);
    const unsigned vbase = lds_u32(F.lds + SC_V) + (unsigned)((8 * fq + (fr >> 2)) * SC_VSTR + (16 * vt + 4 * (lane & 3)) * 2);
    const int r00 = b * SEQ;
    const size_t ocol = (size_t)h * GDV + vs * 64 + 16 * vt + 4 * fq;
    const f32x4 gov = *(const GAS f32x4*)(g_o + vs * 64 + 16 * vt + 4 * fq);
    for (int c = 0; c < GNC; ++c) {
        const int r0 = r00 + c * GL;
        if (c > 0 && tid < 64) { const LAS float* sp = (const LAS float*)(L + SC_SSQ); SSQB[(size_t)(r0 - GL + tid) * 32 + h * 8 + vs] = (sp[tid] + sp[64 + tid]) + (sp[128 + tid] + sp[192 + tid]); }
        if (c + 1 < GNC) SC_LOAD(c + 1);
        v2u szr[2];
#pragma unroll
        for (int i = 0; i < 2; ++i) szr[i] = *(const GAS v2u*)(SZ + (size_t)(r0 + 16 * (2 * hf + i) + fr) * DI + ocol);
        {
            const int tta = w >> 1;
#pragma unroll
            for (int si = 0; si < 2; ++si) {
                const int st = 2 * (w & 1) + si;
                f32x4 a = {0.f, 0.f, 0.f, 0.f};
                if (st <= tta) {
#pragma unroll
                    for (int ks = 0; ks < 4; ++ks) {
                        const bf16x8 A = *(const LAS bf16x8*)(L + SC_KI + (16 * st + fr) * SC_QSTR + 64 * ks + 16 * fq);
                        const bf16x8 B = *(const LAS bf16x8*)(L + SC_QD + (16 * tta + fr) * SC_QSTR + 64 * ks + 16 * fq);
                        a = __builtin_amdgcn_mfma_f32_16x16x32_bf16(A, B, a, 0, 0, 0);
                    }
                }
                const int t = 16 * tta + fr, s0 = 16 * st + 4 * fq;
                a.x = (s0 <= t) ? a.x : 0.f; a.y = (s0 + 1 <= t) ? a.y : 0.f; a.z = (s0 + 2 <= t) ? a.z : 0.f; a.w = (s0 + 3 <= t) ? a.w : 0.f;
                v2u o; o.x = pk2(a.x, a.y); o.y = pk2(a.z, a.w);
                *(LAS v2u*)(F.lds + SC_ATT + t * SC_VSTR + s0 * 2) = o;
            }
        }
        f32x4 oT[4];
#pragma unroll
        for (int tt = 0; tt < 4; ++tt) oT[tt] = (f32x4){0.f, 0.f, 0.f, 0.f};
#pragma unroll
        for (int kb = 0; kb < 2; ++kb) {
            v4u aw; aw.x = pk2(S[2 * kb].x, S[2 * kb].y); aw.y = pk2(S[2 * kb].z, S[2 * kb].w); aw.z = pk2(S[2 * kb + 1].x, S[2 * kb + 1].y); aw.w = pk2(S[2 * kb + 1].z, S[2 * kb + 1].w);
            const bf16x8 A = __builtin_bit_cast(bf16x8, aw);
#pragma unroll
            for (int tt = 0; tt < 4; ++tt) {
                const LAS unsigned char* qp = L + SC_QD + (16 * tt + fr) * SC_QSTR + (64 * hf + 32 * kb + 4 * fq) * 2;
                const s16x4 b0 = *(const LAS s16x4*)qp, b1 = *(const LAS s16x4*)(qp + 32);
                oT[tt] = __builtin_amdgcn_mfma_f32_16x16x32_bf16(A, cat4(b0, b1), oT[tt], 0, 0, 0);
            }
        }
        bf16x8 Vf[2];
        {
            s16x4 v00, v01, v10, v11;
            tr4<0, 4 * SC_VSTR, 32 * SC_VSTR, 36 * SC_VSTR>(vbase, v00, v01, v10, v11);
            __builtin_amdgcn_sched_barrier(0);
            Vf[0] = cat4(v00, v01); Vf[1] = cat4(v10, v11);
            s16x4 k0, k1, k2, k3;
#define SC_KSTEP(i) do { tr4<(i) * 32, (i) * 32 + 4 * SC_QSTR, (i) * 32 + 32 * SC_QSTR, (i) * 32 + 36 * SC_QSTR>(kibase, k0, k1, k2, k3); __builtin_amdgcn_sched_barrier(0); \
            S[i] = __builtin_amdgcn_mfma_f32_16x16x32_bf16(cat4(k0, k1), Vf[0], S[i], 0, 0, 0); S[i] = __builtin_amdgcn_mfma_f32_16x16x32_bf16(cat4(k2, k3), Vf[1], S[i], 0, 0, 0); \
            S[i] = S[i] * *(const LAS f32x4*)(L + SC_DEC + (64 * hf + 16 * (i) + 4 * fq) * 4); } while (0)
            SC_KSTEP(0); SC_KSTEP(1); SC_KSTEP(2); SC_KSTEP(3);
#undef SC_KSTEP
        }
        __syncthreads();
        const bf16x8 Vh = hf ? Vf[1] : Vf[0];
#pragma unroll
        for (int tt = 0; tt < 4; ++tt) {
            if (tt >= 2 * hf) {
                const bf16x8 B = *(const LAS bf16x8*)(L + SC_ATT + (16 * tt + fr) * SC_VSTR + 64 * hf + 16 * fq);
                oT[tt] = __builtin_amdgcn_mfma_f32_16x16x32_bf16(Vh, B, oT[tt], 0, 0, 0);
            }
        }
        {
            LAS f32x4* ox = (LAS f32x4*)(F.lds + SC_OX) + w * 128 + lane;
            if (hf == 0) { ox[0] = oT[2]; ox[64] = oT[3]; } else { ox[0] = oT[0]; ox[64] = oT[1]; }
        }
        __syncthreads();
        {
            const LAS f32x4* px = (const LAS f32x4*)(L + SC_OX) + (w ^ 4) * 128 + lane;
            f32x4 o0 = (hf == 0 ? oT[0] : oT[2]) + px[0], o1 = (hf == 0 ? oT[1] : oT[3]) + px[64];
            float s0 = (o0.x * o0.x + o0.y * o0.y) + (o0.z * o0.z + o0.w * o0.w), s1 = (o1.x * o1.x + o1.y * o1.y) + (o1.z * o1.z + o1.w * o1.w);
            s0 += __shfl_xor(s0, 16); s0 += __shfl_xor(s0, 32); s1 += __shfl_xor(s1, 16); s1 += __shfl_xor(s1, 32);
            if (fq == 0) { LAS float* sp = (LAS float*)(F.lds + SC_SSQ) + vt * 64; sp[16 * (2 * hf) + fr] = s0; sp[16 * (2 * hf + 1) + fr] = s1; }
            const f32x4 y0 = o0 * gov * unpk_lo(szr[0]), y1 = o1 * gov * unpk_lo(szr[1]);
            v2u w0, w1; w0.x = pk2(y0.x, y0.y); w0.y = pk2(y0.z, y0.w); w1.x = pk2(y1.x, y1.y); w1.y = pk2(y1.z, y1.w);
            *(GAS v2u*)(AO + (size_t)((r0 + 16 * (2 * hf) + fr) & rmask) * DI + ocol) = w0;
            *(GAS v2u*)(AO + (size_t)((r0 + 16 * (2 * hf + 1) + fr) & rmask) * DI + ocol) = w1;
        }
        if (c + 1 < GNC) SC_STORE();
        __syncthreads();
    }
    if (tid < 64) { const LAS float* sp = (const LAS float*)(L + SC_SSQ); SSQB[(size_t)(r00 + (GNC - 1) * GL + tid) * 32 + h * 8 + vs] = (sp[tid] + sp[64 + tid]) + (sp[128 + tid] + sp[192 + tid]); }
    __syncthreads();
#undef SC_LOAD
#undef SC_STORE
}

__device__ __forceinline__ void gla_norm_phase(Frame& F) {
    GAS bf16* A = (GAS bf16*)(F.ws + WS_SZ); const GAS float* SSQB = (const GAS float*)(F.ws + WS_SSQB);
    const int gw = F.vcu * NWAVES + F.wave, rows_per = M / (F.G * NWAVES), r0 = gw * rows_per;
    for (int r = r0; r < r0 + rows_per; ++r) {
        const GAS f32x4* sp = (const GAS f32x4*)(SSQB + (size_t)r * 32);
        float ri[4];
#pragma unroll
        for (int hh = 0; hh < 4; ++hh) { const f32x4 a = sp[2 * hh], bq = sp[2 * hh + 1]; ri[hh] = 1.0f / sqrtf(((a.x + a.y) + (a.z + a.w) + (bq.x + bq.y) + (bq.z + bq.w)) * (1.f / GDV) + EPS); }
        GAS v4u* ap = (GAS v4u*)(A + (size_t)r * DI) + F.lane;
#pragma unroll
        for (int i = 0; i < 4; ++i) { v4u v = ap[64 * i]; const float s = ri[i];
            v.x = pk2(bflo(v.x) * s, bfhi(v.x) * s); v.y = pk2(bflo(v.y) * s, bfhi(v.y) * s); v.z = pk2(bflo(v.z) * s, bfhi(v.z) * s); v.w = pk2(bflo(v.w) * s, bfhi(v.w) * s);
            ap[64 * i] = v; }
    }
}

struct Args { const GAS float* in[16]; GAS float* out; GAS unsigned char* ws; int ph_lo, ph_hi, li, pad; };
constexpr int NPH = 2 + 6 * DEPTH;
__host__ __device__ constexpr bool phase_exists(int ph) {
    if (ph < 2) return true;
    const int l = (ph - 2) / 6, k = (ph - 2) % 6;
    if ((l & 1) == 0 && (k == 2 || k == 3)) return false;
    return true;
}

__global__ void __launch_bounds__(NTHREADS, 2) fwd(Args args) {
    extern __shared__ __attribute__((aligned(16))) unsigned char lds[];
    Frame F;
    F.lds = (LAS unsigned char*)lds;
    F.tid = threadIdx.x; F.lane = F.tid & 63; F.wave = __builtin_amdgcn_readfirstlane(F.tid >> 6);
    F.G = gridDim.x; { const int bx = blockIdx.x; F.vcu = (F.G % 8 == 0) ? (bx % 8) * (F.G / 8) + bx / 8 : bx; }
    F.x = args.in[0]; F.c = args.in[1]; F.w_ada = args.in[2]; F.b_ada = args.in[3]; F.g_norm = args.in[4]; F.a_w_in = args.in[5]; F.a_w_s = args.in[6]; F.a_b_s = args.in[7];
    F.a_g_v = args.in[8]; F.a_w_out = args.in[9]; F.b_w_in = args.in[10]; F.b_w_gate_up = args.in[11]; F.b_b_gate = args.in[12]; F.b_g_o = args.in[13]; F.b_w_out = args.in[14]; F.g_final = args.in[15];
    F.out = args.out; F.ws = args.ws;
    volatile LAS unsigned* MISC = (volatile LAS unsigned*)(F.lds + MISC_OFF);
    for (int u = F.tid; u < (LDS_BYTES - LDSCTL_OFF) / 4; u += NTHREADS) ((LAS unsigned*)(F.lds + LDSCTL_OFF))[u] = 0u;
    __syncthreads();
    XcdBarrier bar; bar.bar = (unsigned*)(F.ws + WS_CTL) + CW_BAR; bar.x = 0; bar.st = nullptr;
    const bool multi = (args.ph_hi - args.ph_lo) > 1;
    if (multi) bar = xcd_barrier_post((unsigned*)(F.ws + WS_CTL) + CW_BAR, MISC + 8);

#if defined(PROBE_MASK)
    unsigned long long t_prev = __builtin_amdgcn_s_memrealtime(), t_acc = 0;
#endif
    for (int ph = args.ph_lo; ph < args.ph_hi; ++ph) {
        if (!phase_exists(ph)) continue;
        {
            int t_ = threadIdx.x; asm volatile("" : "+v"(t_)); F.tid = t_; F.lane = t_ & 63; F.wave = __builtin_amdgcn_readfirstlane(t_ >> 6);
            int bx = blockIdx.x; asm volatile("" : "+s"(bx)); F.vcu = (bx % 8) * (F.G / 8) + bx / 8;
            GAS unsigned char* w_ = args.ws; asm volatile("" : "+s"(w_)); F.ws = w_;
        }
#if defined(PROBE_DUP)
        {
            const int l_ = (ph - 2) / 6, k_ = (ph - 2) % 6;
            bool did = true;
            if (PROBE_DUP == 1 && ph == 0) p0_prologue(F);
            else if (PROBE_DUP == 2 && ph == 1) h_pass(F, F.x, 0);
            else if (PROBE_DUP == 3 && ph == 2) { pg8::Gemm g{(const GAS bf16*)(F.ws + WS_H), (const GAS bf16*)(F.ws + WS_WAIN), M, A_IN, D}; pg8::StaticOrder S; S.init(M, A_IN, F.G, (int)blockIdx.x);
                pg8::EpiA1 E{(GAS bf16*)(F.ws + WS_UZ), (GAS bf16*)(F.ws + WS_GV), (GAS float*)(F.ws + WS_SSQA)}; pg8::gemm_phase<pg8::EpiA1, pg8::StaticOrder, true, true>(F.lds, g, S, E); }
            else if (PROBE_DUP == 4 && ph == 8) { pg8::Gemm g{(const GAS bf16*)(F.ws + WS_H), (const GAS bf16*)(F.ws + WS_WBIN), M, B_N, D}; pg8::StaticOrder S; S.init(M, B_N, F.G, (int)blockIdx.x);
                pg8::EpiB1 E{(GAS bf16*)(F.ws + WS_Q), (GAS bf16*)(F.ws + WS_K), (GAS bf16*)(F.ws + WS_V), (GAS bf16*)(F.ws + WS_SZ)}; pg8::gemm_phase<pg8::EpiB1, pg8::StaticOrder, true, true>(F.lds, g, S, E); alr_phase(F, 0); }
            else if (PROBE_DUP == 5 && ph == 6) { pg8::Gemm g{(const GAS bf16*)(F.ws + WS_UZ), (const GAS bf16*)(F.ws + WS_WAOUT), M, D, DI}; pg8::StaticOrder S; S.init(M, D, F.G, (int)blockIdx.x);
                pg8::EpiOut E{F.x, F.out, (const GAS float*)(F.ws + WS_MOD) + 2 * D}; pg8::gemm_phase<pg8::EpiOut, pg8::StaticOrder, false, true>(F.lds, g, S, E); }
            else if (PROBE_DUP == 6 && ph == 1) { for (int q = 0; q < 9; ++q) xcd_barrier(bar); }
            else if (PROBE_DUP == 7 && ph >= 2 && k_ == 1 && (l_ & 1) == 0) mix_phase(F, l_ >> 1, true);
            else if (PROBE_DUP == 8 && ph >= 2 && k_ == 2 && (l_ & 1) == 1) gla_scan_phase(F, l_ >> 1, true);
            else did = false;
            if (did) xcd_barrier(bar);
        }
#endif
        if (ph == 0) p0_prologue(F);
        else if (ph == 1) h_pass(F, F.x, 0);
        else {
            const int l = (ph - 2) / 6, k = (ph - 2) % 6, j = l >> 1; const bool isA = (l & 1) == 0;
            const GAS float* modl = (const GAS float*)(F.ws + WS_MOD) + (size_t)l * BATCH * 3 * D;
            if (k == 0) {
                if (isA) {
                    pg8::Gemm g{(const GAS bf16*)(F.ws + WS_H), (const GAS bf16*)(F.ws + WS_WAIN) + (size_t)j * A_IN * D, M, A_IN, D}; pg8::StaticOrder S; S.init(M, A_IN, F.G, (int)blockIdx.x);
                    pg8::EpiA1 E{(GAS bf16*)(F.ws + WS_UZ), (GAS bf16*)(F.ws + WS_GV), (GAS float*)(F.ws + WS_SSQA)};
                    pg8::gemm_phase<pg8::EpiA1, pg8::StaticOrder, true, true>(F.lds, g, S, E);
                } else {
                    pg8::Gemm g{(const GAS bf16*)(F.ws + WS_H), (const GAS bf16*)(F.ws + WS_WBIN) + (size_t)j * B_INW * D, M, B_N, D}; pg8::StaticOrder S; S.init(M, B_N, F.G, (int)blockIdx.x);
                    pg8::EpiB1 E{(GAS bf16*)(F.ws + WS_Q), (GAS bf16*)(F.ws + WS_K), (GAS bf16*)(F.ws + WS_V), (GAS bf16*)(F.ws + WS_SZ)};
                    pg8::gemm_phase<pg8::EpiB1, pg8::StaticOrder, true, true>(F.lds, g, S, E);
                    alr_phase(F, j);
                }
            } else if (k == 1) {
                if (isA) mix_phase(F, j); else gla_prep_phase(F, j);
            } else if (k == 2) { gla_scan_phase(F, j);
            } else if (k == 3) { gla_norm_phase(F);
            } else if (k == 4) {
                const GAS bf16* A = isA ? (const GAS bf16*)(F.ws + WS_UZ) : (const GAS bf16*)(F.ws + WS_SZ);
                const GAS bf16* Bt = isA ? (const GAS bf16*)(F.ws + WS_WAOUT) + (size_t)j * D * DI : (const GAS bf16*)(F.ws + WS_WBOUT) + (size_t)j * D * DI;
                pg8::Gemm g{A, Bt, M, D, DI}; pg8::StaticOrder S; S.init(M, D, F.G, (int)blockIdx.x);
                pg8::EpiOut E{l == 0 ? F.x : F.out, F.out, modl + 2 * D};
                pg8::gemm_phase<pg8::EpiOut, pg8::StaticOrder, false, true>(F.lds, g, S, E);
            } else {
                if (l + 1 < DEPTH) h_pass(F, F.out, l + 1); else final_norm(F, F.out);
            }
        }
        if (multi && ph + 1 < args.ph_hi) xcd_barrier(bar);
#if defined(PROBE_MASK)
        { __syncthreads(); const unsigned long long t_now = __builtin_amdgcn_s_memrealtime(); if ((PROBE_MASK >> ph) & 1) t_acc += t_now - t_prev; t_prev = t_now; }
#endif
    }
#if defined(PROBE_MASK)
    if (blockIdx.x == 0 && threadIdx.x == 0) { VM_WAIT(); F.out[0] += (float)t_acc * (0.01f * PROBE_SCALE); }
#endif
}

extern "C" void kernel_launch(void* const* d_in, const int* in_sizes, int n_in, void* d_out, int out_size, void* d_ws, size_t ws_size, hipStream_t stream) {
    static int grid = 0;
    if (grid == 0) {
        if (n_in != 16 || in_sizes[0] != M * D || out_size != M * D || ws_size < WS_END) { fprintf(stderr, "kernel_launch: unexpected shapes (n_in %d, in0 %d, out %d, ws %zu); nothing launched\n", n_in, n_in > 0 ? in_sizes[0] : -1, out_size, ws_size); grid = -1; return; }
        int dev = 0, cus = 0;
        if (hipGetDevice(&dev) != hipSuccess || hipDeviceGetAttribute(&cus, hipDeviceAttributeMultiprocessorCount, dev) != hipSuccess) { grid = -1; return; }
        if (hipFuncSetAttribute((const void*)fwd, hipFuncAttributeMaxDynamicSharedMemorySize, LDS_BYTES) != hipSuccess) { fprintf(stderr, "kernel_launch: hipFuncSetAttribute failed\n"); grid = -1; return; }
        (void)hipGetLastError();
        grid = cus;
        if (grid != 256) { fprintf(stderr, "kernel_launch: built for 256 CUs, device has %d; nothing launched\n", cus); grid = -1; return; }
    }
    if (grid < 0) return;
    (void)hipMemsetAsync((char*)d_ws + WS_CTL, 0, CTL_ZERO_BYTES, stream);
    Args a{};
    for (int i = 0; i < 16; ++i) a.in[i] = (const GAS float*)d_in[i];
    a.out = (GAS float*)d_out; a.ws = (GAS unsigned char*)d_ws;
#if MK_PER_PHASE
    unsigned char* ws = (unsigned char*)d_ws;
    for (int ph = 0; ph < NPH; ++ph) {
        if (!phase_exists(ph)) continue;
        const int l = ph >= 2 ? (ph - 2) / 6 : -1, k = ph >= 2 ? (ph - 2) % 6 : -1, j = l >> 1; const bool isA = (l & 1) == 0;
        (void)j; (void)isA; (void)k;
#if NAIVE_MIX
        if (l >= 0 && isA && k == 1) {
            naive_mix<<<1024, 256, 0, stream>>>((const bf16*)(ws + WS_GV), (bf16*)(ws + WS_UZ), (const float*)(ws + WS_SSQA), (const float*)d_in[6] + (size_t)j * SGU_G * SGU_T * SGU_T, (const float*)d_in[7] + (size_t)j * SGU_G * SGU_T, (const float*)d_in[8] + (size_t)j * DI);
            continue;
        }
#endif
#if NAIVE_GLA
        if (l >= 0 && !isA && k == 1) { naive_la<<<M * 512 / 256, 256, 0, stream>>>((const float*)(ws + WS_ALR), (const float*)d_in[11] + (size_t)j * GRANK * 512, (const float*)d_in[12] + (size_t)j * 512, (float*)(ws + WS_LA)); continue; }
        if (l >= 0 && !isA && k == 2) { naive_scan<<<256, 256, 0, stream>>>((const bf16*)(ws + WS_Q), (const bf16*)(ws + WS_K), (bf16*)(ws + WS_V), (const float*)(ws + WS_LA)); continue; }
        if (l >= 0 && !isA && k == 3) { naive_gla_norm<<<M, 256, 0, stream>>>((const bf16*)(ws + WS_V), (bf16*)(ws + WS_SZ), (const float*)d_in[13] + (size_t)j * GDV); continue; }
#endif
        a.ph_lo = ph; a.ph_hi = ph + 1; a.li = 0;
        hipLaunchKernelGGL(fwd, dim3(grid), dim3(NTHREADS), LDS_BYTES, stream, a);
    }
#else
    a.ph_lo = 0; a.ph_hi = NPH; a.li = 0;
    hipLaunchKernelGGL(fwd, dim3(grid), dim3(NTHREADS), LDS_BYTES, stream, a);
#endif
    const hipError_t le = hipPeekAtLastError();
    if (le != hipSuccess) fprintf(stderr, "kernel_launch: launch failed: %s\n", hipGetErrorName(le));
}
```
